# Optimizing an MI355X kernel written in HIP

```python
import jax, jax.numpy as jnp
from jax import lax
import numpy as np

D_MODEL = 1024
BATCH = 8
SEQ = 4096
DEPTH = 1

GRID_W = 64
CTX_LEN = 256
RET_HEADS = 8
RET_DK = 64
RET_DV = 64
RET_W = RET_HEADS * RET_DK
RET_VW = RET_HEADS * RET_DV
RET_CHUNK = 128
NA_HEADS = 8
NA_DH = 64
NA_W = NA_HEADS * NA_DH
NA_WIN_H = 8
NA_WIN_W = 16
D_FF = 4 * D_MODEL
ROPE_BASE = 10000.0
EPS = 1e-6
NEG_INF = -1e30
IN_COLS = 2 * RET_W + 2 * RET_VW + 3 * NA_W + 2 * D_MODEL
SPLIT_AT = (RET_W, 2 * RET_W, 2 * RET_W + RET_VW, 2 * RET_W + 2 * RET_VW,
            2 * RET_W + 2 * RET_VW + NA_W, 2 * RET_W + 2 * RET_VW + 2 * NA_W,
            2 * RET_W + 2 * RET_VW + 3 * NA_W)

kernel_name = 'hybrid_retention_natten_dit_block'


def rmsnorm(x, g):
    xf = x.astype(jnp.float32)
    y = xf * lax.rsqrt(jnp.mean(xf * xf, axis=-1, keepdims=True) + EPS)
    return (y * g.astype(jnp.float32)).astype(x.dtype)


def modulate(x, g, shift, scale):
    return rmsnorm(x, g) * (1 + scale) + shift


def to_heads(t, n_heads):
    b, n, _ = t.shape
    return t.reshape(b, n, n_heads, -1).transpose(0, 2, 1, 3)


def from_heads(t):
    b, h, n, d = t.shape
    return t.transpose(0, 2, 1, 3).reshape(b, n, h * d)


def flip_seq(t):
    return jnp.flip(t, axis=2)


def axial_rope_tables(n, dh):
    pos = jnp.arange(n)
    row = (pos // GRID_W).astype(jnp.float32)
    col = (pos % GRID_W).astype(jnp.float32)
    d_axis = dh // 2
    inv = ROPE_BASE ** (-jnp.arange(0, d_axis, 2, dtype=jnp.float32) / d_axis)
    ang = jnp.concatenate([row[:, None] * inv, col[:, None] * inv], axis=-1)
    return jnp.cos(ang), jnp.sin(ang)


def apply_rope(t, cos, sin):
    half = t.shape[-1] // 2
    t1 = t[..., :half].astype(jnp.float32)
    t2 = t[..., half:].astype(jnp.float32)
    return jnp.concatenate([t1 * cos - t2 * sin, t1 * sin + t2 * cos], axis=-1).astype(t.dtype)


def retention_chunkwise(q, k, v, log_g, init_state, inclusive):
    b, h, n, dk = q.shape
    dv = v.shape[-1]
    L = RET_CHUNK
    nc = n // L
    qc = q.astype(jnp.float32).reshape(b, h, nc, L, dk)
    kc = k.astype(jnp.float32).reshape(b, h, nc, L, dk)
    vc = v.astype(jnp.float32).reshape(b, h, nc, L, dv)
    idx = jnp.arange(L, dtype=jnp.float32)
    diff = idx[:, None] - idx[None, :]
    mask = (diff >= 0) if inclusive else (diff > 0)
    decay = jnp.where(mask, jnp.exp(log_g[:, None, None] * jnp.maximum(diff, 0.0)), 0.0)
    scores = jnp.einsum('bhcid,bhcjd->bhcij', qc, kc) * decay[None, :, None]
    o_intra = jnp.einsum('bhcij,bhcje->bhcie', scores, vc)
    k_w = jnp.exp(log_g[:, None] * (L - 1 - idx)[None, :])
    s_chunk = jnp.einsum('bhcjd,hj,bhcje->cbhde', kc, k_w, vc)
    g_chunk = jnp.exp(log_g * L)[None, :, None, None]

    def step(state, s_c):
        return g_chunk * state + s_c, state

    _, r_before = lax.scan(step, init_state, s_chunk)
    q_w = jnp.exp(log_g[:, None] * (idx + 1)[None, :])
    o_cross = jnp.einsum('bhcid,hi,cbhde->bhcie', qc, q_w, r_before)
    return (o_intra + o_cross).reshape(b, h, n, dv)


def retention_final_state(k, v, log_g):
    n = k.shape[2]
    w = jnp.exp(log_g[:, None] * (n - 1 - jnp.arange(n, dtype=jnp.float32))[None, :])
    return jnp.einsum('bhnd,hn,bhne->bhde', k.astype(jnp.float32), w, v.astype(jnp.float32))


def bidirectional_retention(q, k, v, log_g_fwd, log_g_bwd, state_fwd, state_bwd):
    o_f = retention_chunkwise(q, k, v, log_g_fwd, state_fwd, inclusive=True)
    o_b = retention_chunkwise(flip_seq(q), flip_seq(k), flip_seq(v), log_g_bwd, state_bwd, inclusive=False)
    return o_f + flip_seq(o_b)


def retention_readout(o, g):
    o = o * lax.rsqrt(jnp.mean(o * o, axis=-1, keepdims=True) + EPS)
    return from_heads(o).astype(g.dtype) * jax.nn.silu(g)


def neighborhood_attention(q, k, v, k_ctx, v_ctx, rpb):
    b, h, n, d = q.shape
    rows = n // GRID_W
    kh = min(NA_WIN_H, rows)
    qg = (q.astype(jnp.float32) * d ** -0.5).reshape(b, h, rows, GRID_W, d)
    kg = k.astype(jnp.float32).reshape(b, h, rows, GRID_W, d)
    vg = v.astype(jnp.float32).reshape(b, h, rows, GRID_W, d)
    kc = k_ctx.astype(jnp.float32)
    vc = v_ctx.astype(jnp.float32)
    rpb = rpb.astype(jnp.float32)
    col = jnp.arange(GRID_W)
    c0 = jnp.clip(col - NA_WIN_W // 2, 0, GRID_W - NA_WIN_W)
    col_mask = (col[None, :] >= c0[:, None]) & (col[None, :] < c0[:, None] + NA_WIN_W)
    col_idx = jnp.clip(col[None, :] - col[:, None] + NA_WIN_W - 1, 0, 2 * NA_WIN_W - 2)

    def row_block(r):
        r0 = jnp.clip(r - kh // 2, 0, rows - kh)
        q_r = lax.dynamic_index_in_dim(qg, r, axis=2, keepdims=False)
        k_s = lax.dynamic_slice_in_dim(kg, r0, kh, axis=2)
        v_s = lax.dynamic_slice_in_dim(vg, r0, kh, axis=2)
        row_idx = r0 + jnp.arange(kh) - r + NA_WIN_H - 1
        bias = rpb[:, row_idx][:, :, col_idx].transpose(0, 2, 1, 3)
        s_loc = jnp.einsum('bhqd,bhkwd->bhqkw', q_r, k_s) + bias
        s_loc = jnp.where(col_mask[:, None, :], s_loc, NEG_INF)
        s_ctx = jnp.einsum('bhqd,bhkd->bhqk', q_r, kc)
        s = jnp.concatenate([s_loc.reshape(b, h, GRID_W, kh * GRID_W), s_ctx], axis=-1)
        p = jax.nn.softmax(s, axis=-1)
        p_loc = p[..., :kh * GRID_W].reshape(b, h, GRID_W, kh, GRID_W)
        p_ctx = p[..., kh * GRID_W:]
        return (jnp.einsum('bhqkw,bhkwd->bhqd', p_loc, v_s)
                + jnp.einsum('bhqk,bhkd->bhqd', p_ctx, vc))

    out = lax.map(row_block, jnp.arange(rows))
    return out.transpose(1, 2, 0, 3, 4).reshape(b, h, n, d).astype(q.dtype)


def context_attention(q, k, v):
    d = q.shape[-1]
    s = jnp.einsum('bhqd,bhkd->bhqk', q.astype(jnp.float32), k.astype(jnp.float32)) * d ** -0.5
    p = jax.nn.softmax(s, axis=-1)
    return jnp.einsum('bhqk,bhkd->bhqd', p, v.astype(jnp.float32)).astype(q.dtype)


def merge_branches(y_ret, y_na, gates, w_ret_out, w_na_out, w_o):
    g_ret, g_na = jnp.split(jax.nn.sigmoid(gates), 2, axis=-1)
    return (g_ret * (y_ret @ w_ret_out) + g_na * (y_na @ w_na_out)) @ w_o


def squared_relu_mlp(h, w1, w2):
    return jnp.square(jax.nn.relu(h @ w1)) @ w2


def setup_inputs(seed: int = 0) -> dict:
    key = jax.random.key(seed)
    ks = jax.random.split(key, 18)

    def nrm(k, shape, s):
        return jax.random.normal(k, shape, jnp.float32) * s

    base_logit = jnp.asarray(np.log(2.0 ** (5 + np.arange(RET_HEADS)) - 1.0), jnp.float32)
    return {
        'x': nrm(ks[0], (BATCH, SEQ, D_MODEL), 1.0),
        'c': nrm(ks[1], (BATCH, D_MODEL), 1.0),
        'ctx': nrm(ks[2], (BATCH, CTX_LEN, D_MODEL), 1.0),
        'c_ctx': nrm(ks[3], (D_MODEL,), 1.0),
        'w_ada': nrm(ks[4], (DEPTH, D_MODEL, 6 * D_MODEL), 0.5 * D_MODEL ** -0.5),
        'b_ada': nrm(ks[5], (DEPTH, 6 * D_MODEL), 0.02),
        'norm_pre_mix': 1.0 + nrm(ks[6], (DEPTH, D_MODEL), 0.02),
        'norm_post_mix': 1.0 + nrm(ks[7], (DEPTH, D_MODEL), 0.02),
        'norm_pre_ffn': 1.0 + nrm(ks[8], (DEPTH, D_MODEL), 0.02),
        'norm_post_ffn': 1.0 + nrm(ks[9], (DEPTH, D_MODEL), 0.02),
        'w_in': nrm(ks[10], (DEPTH, D_MODEL, IN_COLS), D_MODEL ** -0.5),
        'ret_decay_logit': base_logit[None, None, :] + nrm(ks[11], (DEPTH, 2, RET_HEADS), 0.05),
        'w_ret_out': nrm(ks[12], (DEPTH, RET_VW, D_MODEL), RET_VW ** -0.5),
        'na_rpb': nrm(ks[13], (DEPTH, NA_HEADS, 2 * NA_WIN_H - 1, 2 * NA_WIN_W - 1), 0.02),
        'w_na_out': nrm(ks[14], (DEPTH, NA_W, D_MODEL), NA_W ** -0.5),
        'w_o': nrm(ks[15], (DEPTH, D_MODEL, D_MODEL), D_MODEL ** -0.5),
        'w_ff1': nrm(ks[16], (DEPTH, D_MODEL, D_FF), D_MODEL ** -0.5),
        'w_ff2': nrm(ks[17], (DEPTH, D_FF, D_MODEL), D_FF ** -0.5),
    }


def reference(x, c, ctx, c_ctx, w_ada, b_ada, norm_pre_mix, norm_post_mix, norm_pre_ffn,
              norm_post_ffn, w_in, ret_decay_logit, w_ret_out, na_rpb, w_na_out, w_o, w_ff1, w_ff2):
    n = x.shape[1]
    cos, sin = axial_rope_tables(n, RET_DK)
    k_scale = RET_DK ** -0.5
    x_lat, x_ctx = x, ctx
    for l in range(DEPTH):
        last = l == DEPTH - 1
        mod_lat = (jax.nn.silu(c) @ w_ada[l] + b_ada[l])[:, None, :]
        mod_ctx = jax.nn.silu(c_ctx) @ w_ada[l] + b_ada[l]
        sh1, sc1, gt1, sh2, sc2, gt2 = jnp.split(mod_lat, 6, axis=-1)
        csh1, csc1, cgt1, csh2, csc2, cgt2 = jnp.split(mod_ctx, 6, axis=-1)
        log_g = jax.nn.log_sigmoid(ret_decay_logit[l].astype(jnp.float32))
        lg_f, lg_b = log_g[0], log_g[1]

        h_lat = modulate(x_lat, norm_pre_mix[l], sh1, sc1)
        h_ctx = modulate(x_ctx, norm_pre_mix[l], csh1, csc1)
        rq, rk, rv, rg, nq, nk, nv, gates = jnp.split(h_lat @ w_in[l], SPLIT_AT, axis=-1)
        crq, crk, crv, crg, cnq, cnk, cnv, cgates = jnp.split(h_ctx @ w_in[l], SPLIT_AT, axis=-1)

        crk_h = to_heads(crk, RET_HEADS) * k_scale
        crv_h = to_heads(crv, RET_HEADS)
        s_f = retention_final_state(crk_h, crv_h, lg_f)
        s_b = retention_final_state(flip_seq(crk_h), flip_seq(crv_h), lg_b)
        q_r = apply_rope(to_heads(rq, RET_HEADS), cos, sin)
        k_r = apply_rope(to_heads(rk, RET_HEADS), cos, sin) * k_scale
        o_ret = bidirectional_retention(q_r, k_r, to_heads(rv, RET_HEADS), lg_f, lg_b, s_f, s_b)
        y_ret = retention_readout(o_ret, rg)

        cnk_h = to_heads(cnk, NA_HEADS)
        cnv_h = to_heads(cnv, NA_HEADS)
        o_na = neighborhood_attention(to_heads(nq, NA_HEADS), to_heads(nk, NA_HEADS),
                                      to_heads(nv, NA_HEADS), cnk_h, cnv_h, na_rpb[l])
        y_na = from_heads(o_na)

        y = merge_branches(y_ret, y_na, gates, w_ret_out[l], w_na_out[l], w_o[l])
        x_lat_next = x_lat + gt1 * rmsnorm(y, norm_post_mix[l])

        if not last:
            zero_state = jnp.zeros((x_ctx.shape[0], RET_HEADS, RET_DK, RET_DV), jnp.float32)
            co_ret = bidirectional_retention(to_heads(crq, RET_HEADS), crk_h, crv_h, lg_f, lg_b,
                                             zero_state, zero_state)
            cy_ret = retention_readout(co_ret, crg)
            cy_na = from_heads(context_attention(to_heads(cnq, NA_HEADS), cnk_h, cnv_h))
            cy = merge_branches(cy_ret, cy_na, cgates, w_ret_out[l], w_na_out[l], w_o[l])
            x_ctx = x_ctx + cgt1 * rmsnorm(cy, norm_post_mix[l])
            ch = modulate(x_ctx, norm_pre_ffn[l], csh2, csc2)
            x_ctx = x_ctx + cgt2 * rmsnorm(squared_relu_mlp(ch, w_ff1[l], w_ff2[l]), norm_post_ffn[l])

        x_lat = x_lat_next
        h2 = modulate(x_lat, norm_pre_ffn[l], sh2, sc2)
        x_lat = x_lat + gt2 * rmsnorm(squared_relu_mlp(h2, w_ff1[l], w_ff2[l]), norm_post_ffn[l])
    return x_lat
```

```cpp
#include <hip/hip_runtime.h>
#include <hip/hip_cooperative_groups.h>
#include <cstdio>
#include <cstdint>
namespace cg = cooperative_groups;

#define PG8_LAS __attribute__((address_space(3)))
#define LAS __attribute__((address_space(3)))
typedef unsigned short bf16_t;
typedef short bf16x8 __attribute__((ext_vector_type(8)));
typedef float f32x4 __attribute__((ext_vector_type(4)));
typedef unsigned u32x4 __attribute__((ext_vector_type(4)));
typedef unsigned u32x2 __attribute__((ext_vector_type(2)));

constexpr int NB = 8, SEQ = 4096, DM = 1024, CTXL = 256, NH = 8, DH = 64, DFF = 4096, INC = 5632;
constexpr int ML = NB * SEQ, MC = NB * CTXL, MT = ML + MC;
constexpr int NCH = 34;
constexpr float LOG2E = 1.4426950408889634f;
constexpr float QSCALE = 0.125f * LOG2E;
constexpr float EPSN = 1e-6f;

constexpr size_t MiB = 1u << 20;
constexpr size_t WS_MOD = 0;
constexpr size_t WS_COS = 256 * 1024, WS_SIN = WS_COS + 4096;
constexpr size_t WS_BAR = 512 * 1024;
constexpr size_t WS_WIN1 = 2 * MiB;
constexpr size_t WS_WIN2 = 11 * MiB;
constexpr size_t WS_WR = 14 * MiB, WS_WN = 15 * MiB;
constexpr size_t WS_WO = 16 * MiB;
constexpr size_t WS_W1 = 18 * MiB;
constexpr size_t WS_W2 = 26 * MiB;
constexpr size_t WS_XN = 34 * MiB;
constexpr size_t WS_SB = WS_XN, WS_H2 = WS_XN;
constexpr size_t WS_RQ = 102 * MiB, WS_RK = 134 * MiB, WS_RG = 166 * MiB, WS_NQ = 198 * MiB, WS_NK = 230 * MiB;
constexpr size_t WS_RB = WS_NK;
constexpr size_t WS_KTF = 264 * MiB, WS_KTB = 298 * MiB, WS_RVT = 332 * MiB, WS_NVT = 366 * MiB;
constexpr size_t WS_Z = WS_KTF;
constexpr size_t WS_Y = WS_RQ;
constexpr size_t WS_U = 166 * MiB;
constexpr size_t WS_F = WS_RQ;
constexpr size_t WS_YNA = 422 * MiB, WS_YRET = 454 * MiB;
constexpr size_t WS_END = 486 * MiB;
constexpr int LDS_BYTES = 147456;

__device__ __forceinline__ unsigned cvt_pk_bf16(float lo, float hi) { unsigned r; asm volatile("v_cvt_pk_bf16_f32 %0, %1, %2" : "=v"(r) : "v"(lo), "v"(hi)); return r; }
__device__ __forceinline__ float bf_lo(unsigned w) { return __builtin_bit_cast(float, w << 16); }
__device__ __forceinline__ float bf_hi(unsigned w) { return __builtin_bit_cast(float, w & 0xffff0000u); }
__device__ __forceinline__ float fexp2(float x) { return __builtin_amdgcn_exp2f(x); }
__device__ __forceinline__ float frcp(float x) { return __builtin_amdgcn_rcpf(x); }
__device__ __forceinline__ float wave_sum(float v) {
#pragma unroll
    for (int o = 1; o < 64; o <<= 1) v += __shfl_xor(v, o);
    return v;
}
__device__ __forceinline__ f32x4 mfma16(bf16x8 a, bf16x8 b, f32x4 c) { return __builtin_amdgcn_mfma_f32_16x16x32_bf16(a, b, c, 0, 0, 0); }
__device__ __forceinline__ float lg2_decay(float logit) {
    const float e = __expf(-logit);
    float l1p;
    if (e < 0.1f) l1p = e * (1.f - e * (0.5f - e * (0.33333334f - e * (0.25f - e * (0.2f - e * (0.16666667f - e * 0.14285715f))))));
    else l1p = __logf(1.f + e);
    return -l1p * LOG2E;
}

namespace pg8 {
constexpr int BM = 256, BK = 64, HALF = 128, HTB = HALF * BK * 2, STAGE_BYTES = 8 * HTB, NXCD = 8, WGM = 8;
__host__ __device__ __forceinline__ int lds_byte(int r, int c) { const int st = (r >> 4) * 2 + (c >> 5), rr = r & 15, cc = c & 31, ob = rr * 64 + cc * 2; return st * 1024 + (ob ^ (((ob >> 9) & 1) << 5)); }
__host__ __device__ __forceinline__ void stage_rc(int b, int& R, int& C) { const int st = b / 1024, sb = b % 1024, swz = sb ^ (((sb >> 9) & 1) << 5); R = (st >> 1) * 16 + swz / 64; C = (st & 1) * 32 + (swz % 64) / 2; }
__host__ __device__ __forceinline__ int perm32(int rho) { const int n = rho >> 4, i = rho & 15; return 8 * (i >> 2) + 4 * n + (i & 3); }
struct Unit { int pm, pn, kind; };
__device__ __forceinline__ void map_tile(int L, int nM, int nN, int& pm, int& pn) {
    const int nwg = nM * nN; int wgid = L;
    { const int q = nwg / NXCD, r = nwg % NXCD, xcd = wgid % NXCD, off = wgid / NXCD; wgid = (xcd < r ? xcd * (q + 1) : r * (q + 1) + (xcd - r) * q) + off; }
    const int nig = WGM * nN, gid = wgid / nig, fm = gid * WGM, gsz = (nM - fm) < WGM ? (nM - fm) : WGM;
    pm = fm + ((wgid % nig) % gsz); pn = (wgid % nig) / gsz;
}

template <class Epi, class Sched, bool ALIGN_EPI = false, bool SP2 = false, bool ABLK = false>
__device__ __forceinline__ void gemm_phase(PG8_LAS unsigned char* lds, const int K, const Sched& S, const Epi& E) {
    const int tid = threadIdx.x, wid = __builtin_amdgcn_readfirstlane(tid >> 6), lane = tid & 63, wr = wid >> 2, wc = wid & 3, fr = lane & 15, fq = lane >> 4;
    const int nt = K / BK;
    unsigned voffA[2], voffB[2];
#pragma unroll
    for (int i = 0; i < 2; ++i) { int R, C; stage_rc(tid * 16 + i * 8192, R, C); const int Rb = Epi::PERM ? ((R & ~31) + perm32(R & 31)) : R;
        voffA[i] = (unsigned)(R * (ABLK ? 64 : K) + C) * 2u; voffB[i] = (unsigned)(Rb * K + C) * 2u; }
    const size_t kstep = (size_t)(BK * 2);
    const size_t hstep = (size_t)HALF * K * 2;
    const size_t tstep = 2 * hstep;
    const size_t kstepA = ABLK ? (size_t)32768 : kstep, hstepA = ABLK ? (size_t)16384 : hstep;
    const unsigned ldsw = (unsigned)wid * 1024u;
    const int aoff = lds_byte(wr * 64 + fr, fq * 8), boff = lds_byte(wc * 32 + fr, fq * 8);
#define PG8_SA(b, h) (((b) * 2 + (h)) * HTB)
#define PG8_SB(b, h) ((4 + (b) * 2 + (h)) * HTB)
#define PG8_STAGE(bufoff, gbase, voff) do { _Pragma("unroll") for (int _i = 0; _i < 2; ++_i) \
        __builtin_amdgcn_global_load_lds((const unsigned*)((const char*)(gbase) + (voff)[_i]), (PG8_LAS unsigned*)(lds + (bufoff) + ldsw + _i * 8192), 16, 0, 0); } while (0)
#define PG8_LDA(dst, b, h) do { _Pragma("unroll") for (int m = 0; m < 4; ++m) _Pragma("unroll") for (int k = 0; k < 2; ++k) dst[m][k] = *(const PG8_LAS bf16x8*)(lds + PG8_SA(b, h) + aoff + m * 2048 + k * 1024); } while (0)
#define PG8_LDB(dst, b, h) do { _Pragma("unroll") for (int n = 0; n < 2; ++n) _Pragma("unroll") for (int k = 0; k < 2; ++k) dst[n][k] = *(const PG8_LAS bf16x8*)(lds + PG8_SB(b, h) + boff + n * 2048 + k * 1024); } while (0)
#define PG8_MMA(ai, bj, At, Bt) do { __builtin_amdgcn_s_setprio(1); _Pragma("unroll") for (int m = 0; m < 4; ++m) _Pragma("unroll") for (int n = 0; n < 2; ++n) _Pragma("unroll") for (int k = 0; k < 2; ++k) \
        acc[ai][bj][m][n] = __builtin_amdgcn_mfma_f32_16x16x32_bf16(Bt[n][k], At[m][k], acc[ai][bj][m][n], 0, 0, 0); __builtin_amdgcn_s_setprio(0); } while (0)
#define PG8_WAIT_V(n) asm volatile("s_waitcnt vmcnt(" #n ")" ::: "memory")
#define PG8_WAIT_L(n) asm volatile("s_waitcnt lgkmcnt(" #n ")" ::: "memory")
#define PG8_BAR __builtin_amdgcn_s_barrier()
#define PG8_SCHED __builtin_amdgcn_sched_barrier(0)
    Unit cur, nxt; int ui = 0;
    if (!S.next(0, cur)) return;
    f32x4 acc[2][2][4][2];
#pragma unroll
    for (int a = 0; a < 2; ++a)
#pragma unroll
        for (int b = 0; b < 2; ++b)
#pragma unroll
            for (int m = 0; m < 4; ++m)
#pragma unroll
                for (int n = 0; n < 2; ++n) acc[a][b][m][n] = (f32x4){0.f, 0.f, 0.f, 0.f};
    bf16x8 At[4][2], B0[2][2], B1[2][2];
    const char* cA; const char* cB; S.ptrs(cur, tstep, cA, cB);
    if constexpr (SP2) {
        PG8_STAGE(PG8_SB(0, 0), cB, voffB); PG8_STAGE(PG8_SB(0, 1), cB + hstep, voffB); PG8_STAGE(PG8_SA(0, 0), cA, voffA); PG8_STAGE(PG8_SA(0, 1), cA + hstepA, voffA);
        if (wr == 1) PG8_BAR;
        PG8_WAIT_V(2); PG8_BAR;
        PG8_STAGE(PG8_SB(1, 0), cB + kstep, voffB); PG8_STAGE(PG8_SA(1, 0), cA + kstepA, voffA); PG8_STAGE(PG8_SB(1, 1), cB + hstep + kstep, voffB);
        PG8_WAIT_V(6); PG8_BAR;
    } else {
        PG8_STAGE(PG8_SB(0, 0), cB, voffB); PG8_STAGE(PG8_SA(0, 0), cA, voffA); PG8_STAGE(PG8_SB(0, 1), cB + hstep, voffB); PG8_STAGE(PG8_SA(0, 1), cA + hstepA, voffA);
        if (wr == 1) PG8_BAR;
        PG8_WAIT_V(4); PG8_BAR;
        PG8_STAGE(PG8_SB(1, 0), cB + kstep, voffB); PG8_STAGE(PG8_SA(1, 0), cA + kstepA, voffA); PG8_STAGE(PG8_SB(1, 1), cB + hstep + kstep, voffB);
        PG8_WAIT_V(6); PG8_BAR;
    }
    for (;;) {
        const bool has_next = S.next(ui + 1, nxt);
        const char* nA = cA; const char* nB = cB; if (has_next) S.ptrs(nxt, tstep, nA, nB);
        for (int t = 0; t < nt; t += 2) {
            const bool last = (t == nt - 2);
            const char* a1 = cA + (size_t)(t + 1) * kstepA;
            const char* a2 = last ? nA : cA + (size_t)(t + 2) * kstepA; const char* b2 = last ? nB : cB + (size_t)(t + 2) * kstep;
            const char* a3 = a2 + kstepA; const char* b3 = b2 + kstep;
            if constexpr (SP2) {
            PG8_LDB(B0, 0, 0); PG8_LDB(B1, 0, 1); PG8_SCHED; PG8_LDA(At, 0, 0); PG8_STAGE(PG8_SA(1, 1), a1 + hstepA, voffA);
            PG8_WAIT_V(8); PG8_WAIT_L(0); PG8_BAR; PG8_MMA(0, 0, At, B0); PG8_MMA(0, 1, At, B1); PG8_BAR; PG8_SCHED;
            PG8_LDA(At, 0, 1); PG8_STAGE(PG8_SB(0, 0), b2, voffB); PG8_STAGE(PG8_SB(0, 1), b2 + hstep, voffB); PG8_STAGE(PG8_SA(0, 0), a2, voffA);
            PG8_WAIT_V(8); PG8_WAIT_L(0); PG8_BAR; PG8_MMA(1, 0, At, B0); PG8_MMA(1, 1, At, B1); PG8_BAR; PG8_SCHED;
            PG8_LDB(B0, 1, 0); PG8_LDB(B1, 1, 1); PG8_SCHED; PG8_LDA(At, 1, 0); PG8_STAGE(PG8_SA(0, 1), a2 + hstepA, voffA);
            PG8_WAIT_V(8); PG8_WAIT_L(0); PG8_BAR; PG8_MMA(0, 0, At, B0); PG8_MMA(0, 1, At, B1); PG8_BAR; PG8_SCHED;
            PG8_LDA(At, 1, 1); PG8_STAGE(PG8_SB(1, 0), b3, voffB); PG8_STAGE(PG8_SB(1, 1), b3 + hstep, voffB); PG8_STAGE(PG8_SA(1, 0), a3, voffA);
            PG8_WAIT_V(8); PG8_WAIT_L(0); PG8_BAR; PG8_MMA(1, 0, At, B0); PG8_MMA(1, 1, At, B1); PG8_BAR; PG8_SCHED;
            } else {
            PG8_LDB(B0, 0, 0); PG8_SCHED; PG8_LDA(At, 0, 0); PG8_STAGE(PG8_SA(1, 1), a1 + hstepA, voffA);
            PG8_WAIT_L(8); PG8_BAR; PG8_WAIT_L(0); PG8_MMA(0, 0, At, B0); PG8_BAR; PG8_SCHED;
            PG8_LDB(B1, 0, 1); PG8_STAGE(PG8_SB(0, 0), b2, voffB);
            PG8_BAR; PG8_WAIT_L(0); PG8_MMA(0, 1, At, B1); PG8_BAR;
            PG8_LDA(At, 0, 1); PG8_STAGE(PG8_SA(0, 0), a2, voffA);
            PG8_BAR; PG8_WAIT_L(0); PG8_MMA(1, 0, At, B0); PG8_BAR; PG8_SCHED;
            PG8_STAGE(PG8_SB(0, 1), b2 + hstep, voffB);
            PG8_WAIT_V(6); PG8_BAR; PG8_MMA(1, 1, At, B1); PG8_BAR;
            PG8_LDB(B0, 1, 0); PG8_SCHED; PG8_LDA(At, 1, 0); PG8_STAGE(PG8_SA(0, 1), a2 + hstepA, voffA);
            PG8_WAIT_L(8); PG8_BAR; PG8_WAIT_L(0); PG8_MMA(0, 0, At, B0); PG8_BAR; PG8_SCHED;
            PG8_LDB(B1, 1, 1); PG8_STAGE(PG8_SB(1, 0), b3, voffB);
            PG8_BAR; PG8_WAIT_L(0); PG8_MMA(0, 1, At, B1); PG8_BAR;
            PG8_LDA(At, 1, 1); PG8_STAGE(PG8_SA(1, 0), a3, voffA);
            PG8_BAR; PG8_WAIT_L(0); PG8_MMA(1, 0, At, B0); PG8_BAR; PG8_SCHED;
            PG8_STAGE(PG8_SB(1, 1), b3 + hstep, voffB);
            PG8_WAIT_V(6); PG8_BAR; PG8_MMA(1, 1, At, B1); PG8_BAR;
            }
        }
        if constexpr (ALIGN_EPI) { if (wr == 0) PG8_BAR; }
        E(acc, cur, wr, wc, fr, fq);
        if (!has_next) break;
#pragma unroll
        for (int a = 0; a < 2; ++a)
#pragma unroll
            for (int b = 0; b < 2; ++b)
#pragma unroll
                for (int m = 0; m < 4; ++m)
#pragma unroll
                    for (int n = 0; n < 2; ++n) acc[a][b][m][n] = (f32x4){0.f, 0.f, 0.f, 0.f};
        cur = nxt; cA = nA; cB = nB; ++ui;
        if constexpr (ALIGN_EPI) { if (wr == 1) PG8_BAR; }
    }
    PG8_WAIT_V(0);
    if constexpr (!ALIGN_EPI) { if (wr == 0) PG8_BAR; }
    PG8_BAR;
#undef PG8_SA
#undef PG8_SB
#undef PG8_STAGE
#undef PG8_LDA
#undef PG8_LDB
#undef PG8_MMA
#undef PG8_WAIT_V
#undef PG8_WAIT_L
#undef PG8_BAR
#undef PG8_SCHED
}
}

struct SchedSimple {
    const char* A; const char* B; int nM, nN, G, c, kind;
    __device__ __forceinline__ bool next(int i, pg8::Unit& u) const { const int L = i * G + c; if (L >= nM * nN) return false; pg8::map_tile(L, nM, nN, u.pm, u.pn); u.kind = kind; return true; }
    __device__ __forceinline__ void ptrs(const pg8::Unit& u, size_t tstep, const char*& a, const char*& b) const { a = A + (size_t)u.pm * tstep; b = B + (size_t)u.pn * tstep; }
};
struct SchedInproj {
    const char* XN; const char* W1; const char* W2; int G, c;
    static constexpr int N0 = 128 * 18, N1 = 4 * 136, N2 = 32;
    __device__ __forceinline__ bool next(int i, pg8::Unit& u) const {
        const int L = i * G + c;
        if (L < N0) { pg8::map_tile(L, 128, 18, u.pm, u.pn); u.kind = 0; return true; }
        if (L < N0 + N1) { pg8::map_tile(L - N0, 4, 136, u.pm, u.pn); u.kind = 1; return true; }
        if (L < N0 + N1 + N2) { const int l = L - N0 - N1; u.pm = 128 + (l & 7); u.pn = ((l >> 3) < 2) ? (2 + (l >> 3)) : (6 + (l >> 3)); u.kind = 0; return true; }
        return false;
    }
    __device__ __forceinline__ void ptrs(const pg8::Unit& u, size_t tstep, const char*& a, const char*& b) const {
        if (u.kind == 0) { a = XN + (size_t)u.pm * tstep; b = W1 + (size_t)u.pn * tstep; }
        else { a = W2 + (size_t)u.pm * tstep; b = XN + (size_t)u.pn * tstep; }
    }
};

typedef const f32x4 (&AccRef)[2][2][4][2];
__device__ __forceinline__ u32x4 pack8(f32x4 v0, f32x4 v1) { u32x4 w; w.x = cvt_pk_bf16(v0[0], v0[1]); w.y = cvt_pk_bf16(v0[2], v0[3]); w.z = cvt_pk_bf16(v1[0], v1[1]); w.w = cvt_pk_bf16(v1[2], v1[3]); return w; }

constexpr size_t TL_LAT = (size_t)64 * 128 * 2048;
__device__ __forceinline__ size_t tl_off(int tok, int hh, int d) {
    if (tok < ML) { const int b = tok >> 12, n = tok & 4095; return ((size_t)(((b * 8 + hh) * 128 + (n >> 5)) * 64 + d)) * 32 + (n & 31); }
    const int t = tok - ML, b = t >> 8, j = t & 255; return TL_LAT + ((size_t)(((b * 8 + hh) * 8 + (j >> 5)) * 64 + d)) * 32 + (j & 31);
}
struct EpiInproj {
    static constexpr bool PERM = true;
    unsigned char* ws; bf16_t* gates; LAS const float* cosT; LAS const float* sinT; const float* dlog;
    __device__ __forceinline__ void rowmajor(AccRef acc, const pg8::Unit& u, int wr, int wc, int fr, int fq) const {
        const int ct = u.pn; bf16_t* base; int ld, colt, typ;
        if (ct < 10) { typ = ct >> 1; base = (bf16_t*)(ws + WS_RQ + (size_t)typ * 32 * MiB); ld = 512; colt = (ct & 1) * 256; }
        else { typ = 5; base = gates; ld = 2048; colt = (ct - 10) * 256; }
        const int row0 = u.pm * 256 + wr * 64 + fr, col0 = colt + wc * 32 + 8 * fq;
#pragma unroll
        for (int ai = 0; ai < 2; ++ai)
#pragma unroll
            for (int m = 0; m < 4; ++m) {
                const int row = row0 + ai * 128 + m * 16; const int nl = row & 4095, rowpos = nl >> 6, colpos = nl & 63;
#pragma unroll
                for (int bj = 0; bj < 2; ++bj) {
                    const int col = col0 + bj * 128; f32x4 v0 = acc[ai][bj][m][0], v1 = acc[ai][bj][m][1];
                    if (typ == 1 && row >= ML) { v0 = v0 * 0.125f; v1 = v1 * 0.125f; }
                    else if (typ <= 1) {
                        const int i0 = (col & 63) >> 1, pos = (i0 < 16) ? rowpos : colpos, f0 = i0 & 15;
                        const f32x4 cs = *(LAS const f32x4*)(cosT + pos * 16 + f0), sn = *(LAS const f32x4*)(sinT + pos * 16 + f0);
                        const float sc = (typ == 1) ? 0.125f : 1.f;
                        f32x4 a, b;
                        a[0] = (v0[0] * cs[0] - v0[1] * sn[0]) * sc; a[1] = (v0[0] * sn[0] + v0[1] * cs[0]) * sc;
                        a[2] = (v0[2] * cs[1] - v0[3] * sn[1]) * sc; a[3] = (v0[2] * sn[1] + v0[3] * cs[1]) * sc;
                        b[0] = (v1[0] * cs[2] - v1[1] * sn[2]) * sc; b[1] = (v1[0] * sn[2] + v1[1] * cs[2]) * sc;
                        b[2] = (v1[2] * cs[3] - v1[3] * sn[3]) * sc; b[3] = (v1[2] * sn[3] + v1[3] * cs[3]) * sc;
                        v0 = a; v1 = b;
                    } else if (typ == 3) { v0 = v0 * QSCALE; v1 = v1 * QSCALE; }
                    else if (typ == 5) {
#pragma unroll
                        for (int e = 0; e < 4; ++e) { v0[e] = frcp(1.f + fexp2(-v0[e] * LOG2E)); v1[e] = frcp(1.f + fexp2(-v1[e] * LOG2E)); }
                    }
                    if (typ == 1) {
                        const int hh = col >> 6;
                        const bool odd = (fr & 1) != 0;
                        const size_t to = tl_off(row & ~1, hh, (col & 63) + (odd ? 4 : 0));
                        unsigned* tf = (unsigned*)((bf16_t*)(ws + WS_KTF) + to);
#pragma unroll
                        for (int e = 0; e < 4; ++e) {
                            const float mine = odd ? v1[e] : v0[e], send = odd ? v0[e] : v1[e];
                            const float rf = __builtin_bit_cast(float, __builtin_amdgcn_update_dpp(0, __builtin_bit_cast(int, send), 0xB1, 0xF, 0xF, false));
                            tf[e * 16] = odd ? cvt_pk_bf16(rf, mine) : cvt_pk_bf16(mine, rf);
                        }
                        if (row >= ML) continue;
                    }
                    size_t doff;
                    if (typ == 5) doff = ((size_t)((row >> 8) * 8 + (col >> 8)) << 16) + (size_t)((row & 255) * 256 + (col & 255));
                    else if (row < ML) doff = ((size_t)(((row >> 12) * 8 + (col >> 6)) * 4096 + (row & 4095))) * 64 + (col & 63);
                    else doff = (size_t)ML * 512 + ((size_t)((((row - ML) >> 8) * 8 + (col >> 6)) * 256 + ((row - ML) & 255))) * 64 + (col & 63);
                    *(u32x4*)(base + doff) = pack8(v0, v1);
                }
            }
    }
    __device__ __forceinline__ void transposed(AccRef acc, const pg8::Unit& u, int wr, int wc, int fr, int fq) const {
        const int region = u.pm >> 1;
        const int tok0 = u.pn * 256 + wc * 32 + 8 * fq;
        bf16_t* base = (bf16_t*)(ws + (region == 0 ? WS_RVT : WS_NVT));
        const int rowb = (u.pm & 1) * 256 + wr * 64 + fr;
#pragma unroll
        for (int ai = 0; ai < 2; ++ai)
#pragma unroll
            for (int m = 0; m < 4; ++m) {
                const int row = rowb + ai * 128 + m * 16;
#pragma unroll
                for (int bj = 0; bj < 2; ++bj) *(u32x4*)(base + tl_off(tok0 + bj * 128, row >> 6, row & 63)) = pack8(acc[ai][bj][m][0], acc[ai][bj][m][1]);
            }
    }
    __device__ __forceinline__ void operator()(AccRef acc, const pg8::Unit& u, int wr, int wc, int fr, int fq) const {
        if (u.kind == 0) rowmajor(acc, u, wr, wc, fr, fq); else transposed(acc, u, wr, wc, fr, fq);
    }
};

template <int TERM> struct EpiMerge {
    static constexpr bool PERM = true;
    const bf16_t* gates; bf16_t* Z;
    __device__ __forceinline__ void operator()(AccRef acc, const pg8::Unit& u, int wr, int wc, int fr, int fq) const {
        const int row0 = u.pm * 256 + wr * 64 + fr, col0 = u.pn * 256 + wc * 32 + 8 * fq;
#pragma unroll
        for (int ai = 0; ai < 2; ++ai)
#pragma unroll
            for (int m = 0; m < 4; ++m) {
                const int row = row0 + ai * 128 + m * 16;
#pragma unroll
                for (int bj = 0; bj < 2; ++bj) {
                    const int col = col0 + bj * 128;
                    const u32x4 g = *(const u32x4*)(gates + (((size_t)((row >> 8) * 8 + TERM * 4 + (col >> 8))) << 16) + (size_t)((row & 255) * 256 + (col & 255)));
                    f32x4 v0 = acc[ai][bj][m][0], v1 = acc[ai][bj][m][1];
                    v0[0] *= bf_lo(g.x); v0[1] *= bf_hi(g.x); v0[2] *= bf_lo(g.y); v0[3] *= bf_hi(g.y);
                    v1[0] *= bf_lo(g.z); v1[1] *= bf_hi(g.z); v1[2] *= bf_lo(g.w); v1[3] *= bf_hi(g.w);
                    bf16_t* zp = Z + (size_t)row * 1024 + col;
                    if (TERM == 1) {
                        const u32x4 z = *(const u32x4*)zp;
                        v0[0] += bf_lo(z.x); v0[1] += bf_hi(z.x); v0[2] += bf_lo(z.y); v0[3] += bf_hi(z.y);
                        v1[0] += bf_lo(z.z); v1[1] += bf_hi(z.z); v1[2] += bf_lo(z.w); v1[3] += bf_hi(z.w);
                    }
                    *(u32x4*)zp = pack8(v0, v1);
                }
            }
    }
};

template <int ACT, int TILED = 0> struct EpiPlain {
    static constexpr bool PERM = true;
    bf16_t* O; int ld;
    __device__ __forceinline__ void operator()(AccRef acc, const pg8::Unit& u, int wr, int wc, int fr, int fq) const {
        const int row0 = u.pm * 256 + wr * 64 + fr, col0 = u.pn * 256 + wc * 32 + 8 * fq;
#pragma unroll
        for (int ai = 0; ai < 2; ++ai)
#pragma unroll
            for (int m = 0; m < 4; ++m) {
                const int row = row0 + ai * 128 + m * 16;
#pragma unroll
                for (int bj = 0; bj < 2; ++bj) {
                    f32x4 v0 = acc[ai][bj][m][0], v1 = acc[ai][bj][m][1];
                    if (ACT == 1) {
#pragma unroll
                        for (int e = 0; e < 4; ++e) { const float a = fmaxf(v0[e], 0.f), b = fmaxf(v1[e], 0.f); v0[e] = a * a; v1[e] = b * b; }
                    }
                    const int col = col0 + bj * 128;
                    const size_t off = (TILED == 2) ? ((((size_t)((row >> 8) * (ld >> 6) + (col >> 6))) * 256 + (row & 255)) * 64 + (col & 63)) : (TILED == 1) ? ((((size_t)((row >> 8) * (ld >> 8) + (col >> 8))) << 16) + (size_t)((row & 255) * 256 + (col & 255))) : ((size_t)row * ld + col);
                    *(u32x4*)(O + off) = pack8(v0, v1);
                }
            }
    }
};

__device__ __forceinline__ void conv_item(const float* W, int K, int N, int mat, unsigned char* ws, LAS float* scr, int item, int lane) {
    const int nblk = N / 32, kb = item / nblk, nb = item % nblk, k0 = 64 * kb, n0 = 32 * nb;
#pragma unroll 8
    for (int i = 0; i < 32; ++i) { const int kk = 2 * i + (lane >> 5); scr[kk * 33 + (lane & 31)] = W[(size_t)(k0 + kk) * N + n0 + (lane & 31)]; }
    asm volatile("s_waitcnt vmcnt(0) lgkmcnt(0)" ::: "memory");
    const int c = lane & 7;
#pragma unroll
    for (int j = 0; j < 4; ++j) {
        const int n = (lane >> 3) + 8 * j; const LAS float* s = scr + (8 * c) * 33 + n;
        u32x4 o; o.x = cvt_pk_bf16(s[0 * 33], s[1 * 33]); o.y = cvt_pk_bf16(s[2 * 33], s[3 * 33]); o.z = cvt_pk_bf16(s[4 * 33], s[5 * 33]); o.w = cvt_pk_bf16(s[6 * 33], s[7 * 33]);
        const int gn = n0 + n;
        bf16_t* d0; bf16_t* d1 = nullptr;
        bf16_t* win1 = (bf16_t*)(ws + WS_WIN1); bf16_t* win2 = (bf16_t*)(ws + WS_WIN2);
        if (mat == 0) {
            if (gn < 1024) {
                const int which = gn >> 9, cc = gn & 511, hh = cc >> 6, d = cc & 63, p = (d < 32) ? 2 * d : 2 * (d - 32) + 1;
                d0 = win1 + (size_t)(which * 512 + hh * 64 + p) * 1024;
            } else if (gn < 1536) d0 = win2 + (size_t)(gn - 1024) * 1024;
            else if (gn < 2048) d0 = win1 + (size_t)(1024 + gn - 1536) * 1024;
            else if (gn < 2560) d0 = win1 + (size_t)(1536 + gn - 2048) * 1024;
            else if (gn < 3072) d0 = win1 + (size_t)(2048 + gn - 2560) * 1024;
            else if (gn < 3584) d0 = win2 + (size_t)(512 + gn - 3072) * 1024;
            else d0 = win1 + (size_t)(2560 + gn - 3584) * 1024;
        } else {
            const size_t off = (mat == 1) ? WS_WR : (mat == 2) ? WS_WN : (mat == 3) ? WS_WO : (mat == 4) ? WS_W1 : WS_W2;
            d0 = (bf16_t*)(ws + off) + (size_t)gn * K;
        }
        *(u32x4*)(d0 + k0 + 8 * c) = o;
        if (d1) *(u32x4*)(d1 + k0 + 8 * c) = o;
    }
    asm volatile("s_waitcnt lgkmcnt(0)" ::: "memory");
}

__device__ __forceinline__ void ada_item(int it, const float* cvec, const float* cctx, const float* w_ada, const float* b_ada, float* MOD, LAS float* lds, int tid) {
    LAS float* sl = lds;
    LAS float* red = lds + 9 * 1024;
    for (int idx = tid; idx < 9 * 1024; idx += 512) { const int bb = idx >> 10, k = idx & 1023; const float v = (bb < 8) ? cvec[bb * 1024 + k] : cctx[k]; sl[idx] = v * frcp(1.f + __expf(-v)); }
    __syncthreads();
    const int col = tid & 31, ks = tid >> 5, j0 = it * 32;
    float a0 = 0.f, a1 = 0.f, a2 = 0.f, a3 = 0.f, a4 = 0.f, a5 = 0.f, a6 = 0.f, a7 = 0.f, a8 = 0.f;
#pragma unroll 16
    for (int kk = 0; kk < 64; ++kk) {
        const int k = ks * 64 + kk; const float w = w_ada[(size_t)k * 6144 + j0 + col];
        a0 += sl[k] * w; a1 += sl[1024 + k] * w; a2 += sl[2048 + k] * w; a3 += sl[3072 + k] * w; a4 += sl[4096 + k] * w;
        a5 += sl[5120 + k] * w; a6 += sl[6144 + k] * w; a7 += sl[7168 + k] * w; a8 += sl[8192 + k] * w;
    }
    LAS float* rp = red + ks * 288 + col;
    rp[0] = a0; rp[32] = a1; rp[64] = a2; rp[96] = a3; rp[128] = a4; rp[160] = a5; rp[192] = a6; rp[224] = a7; rp[256] = a8;
    __syncthreads();
    if (tid < 288) { float s = 0.f;
#pragma unroll
        for (int q = 0; q < 16; ++q) s += red[q * 288 + tid];
        const int bb = tid >> 5, cc = tid & 31; MOD[bb * 6144 + j0 + cc] = s + b_ada[j0 + cc]; }
    __syncthreads();
}

__device__ __forceinline__ void modulate_row(const float* src, const float* g, const float* sh, const float* sc, bf16_t* dst, int lane) {
    f32x4 v[4]; float ss = 0.f;
#pragma unroll
    for (int j = 0; j < 4; ++j) { v[j] = *(const f32x4*)(src + 4 * lane + 256 * j); ss += (v[j][0] * v[j][0] + v[j][1] * v[j][1]) + (v[j][2] * v[j][2] + v[j][3] * v[j][3]); }
    const float rinv = rsqrtf(wave_sum(ss) * (1.f / 1024.f) + EPSN);
#pragma unroll
    for (int j = 0; j < 4; ++j) {
        const int c = 4 * lane + 256 * j;
        const f32x4 gg = *(const f32x4*)(g + c), s1 = *(const f32x4*)(sc + c), s0 = *(const f32x4*)(sh + c);
        f32x4 h;
#pragma unroll
        for (int e = 0; e < 4; ++e) h[e] = v[j][e] * rinv * gg[e] * (1.f + s1[e]) + s0[e];
        u32x2 w; w.x = cvt_pk_bf16(h[0], h[1]); w.y = cvt_pk_bf16(h[2], h[3]);
        *(u32x2*)(dst + c) = w;
    }
}

__host__ __device__ constexpr bool navalid(int g, int t) { return (g == 0) ? (t < 2) : (g == 3) ? (t >= 2) : true; }
__host__ __device__ constexpr int napidx(int g, int t) { int n = 0; for (int gg = 0; gg < 4; ++gg) for (int tt = 0; tt < 4; ++tt) { if (gg == g && tt == t) return n; if (navalid(gg, tt)) ++n; } return n; }

template <int T0, int T1>
__device__ __forceinline__ void na_kload(bf16x8 (&kf)[4][2], const char* kbase, unsigned koff) {
#pragma unroll
    for (int t = T0; t < T1; ++t)
#pragma unroll
        for (int kh = 0; kh < 2; ++kh) kf[t][kh] = *(const bf16x8*)(kbase + ((32 * (t >> 1) + 4 * (t & 1)) * 128 + kh * 64) + (size_t)koff);
}

template <bool LOCAL>
__device__ __forceinline__ void na_step(f32x4 (&o)[4][4], LAS const bf16x8* qlds, float (&mrow)[4], float (&lsum)[4], const bf16x8 (&kf)[4][2], const bf16x8 (&vf)[4][2],
                                        LAS const float* rpbrow, unsigned long long vmask_in) {
    unsigned vm_lo = (unsigned)vmask_in, vm_hi = (unsigned)(vmask_in >> 32);
    asm volatile("" : "+v"(vm_lo), "+v"(vm_hi));
    const f32x4 zero = {0.f, 0.f, 0.f, 0.f};
#pragma unroll
    for (int g = 0; g < 4; ++g) {
        f32x4 s[4];
        float mx = -1e30f;
        const bf16x8 q0 = qlds[(g * 2 + 0) * 64], q1 = qlds[(g * 2 + 1) * 64];
#pragma unroll
        for (int t = 0; t < 4; ++t) {
            if (!LOCAL || navalid(g, t)) {
                f32x4 a = mfma16(kf[t][0], q0, zero); a = mfma16(kf[t][1], q1, a);
                if (LOCAL) {
                    if (g == 1 || g == 2) {
#pragma unroll
                        for (int j = 0; j < 4; ++j) a[j] += rpbrow[15 * 128 + 32 * (t >> 1) + 4 * (t & 1) + j - 16 * g];
                    } else {
#pragma unroll
                        for (int j = 0; j < 4; ++j) {
                            const float bias = rpbrow[32 * (t >> 1) + 4 * (t & 1) + j - 16 * g];
                            const int bit = napidx(g, t) * 4 + j;
                            const bool ok = ((bit < 32 ? (vm_lo >> (bit & 31)) : (vm_hi >> (bit & 31))) & 1u) != 0u;
                            a[j] = ok ? (a[j] + bias) : -1e30f;
                        }
                    }
                }
                s[t] = a;
                mx = fmaxf(mx, fmaxf(fmaxf(a[0], a[1]), fmaxf(a[2], a[3])));
            } else s[t] = zero;
        }
        if (__any(mx > mrow[g] + 16.f)) {
            mx = fmaxf(mx, __shfl_xor(mx, 16)); mx = fmaxf(mx, __shfl_xor(mx, 32));
            const float mnew = fmaxf(mrow[g], mx), alpha = fexp2(mrow[g] - mnew); mrow[g] = mnew;
            lsum[g] = lsum[g] * alpha;
#pragma unroll
            for (int dt = 0; dt < 4; ++dt) o[g][dt] = o[g][dt] * alpha;
        }
        const float mref = mrow[g];
        float psum = 0.f;
#pragma unroll
        for (int t = 0; t < 4; ++t) if (!LOCAL || navalid(g, t)) {
#pragma unroll
            for (int j = 0; j < 4; ++j) { const float p = fexp2(s[t][j] - mref); psum += p; s[t][j] = p; }
        }
        lsum[g] += psum;
#pragma unroll
        for (int sl = 0; sl < 2; ++sl) {
            if (!LOCAL || navalid(g, 2 * sl)) {
                u32x4 w; w.x = cvt_pk_bf16(s[2 * sl][0], s[2 * sl][1]); w.y = cvt_pk_bf16(s[2 * sl][2], s[2 * sl][3]);
                w.z = cvt_pk_bf16(s[2 * sl + 1][0], s[2 * sl + 1][1]); w.w = cvt_pk_bf16(s[2 * sl + 1][2], s[2 * sl + 1][3]);
                const bf16x8 pf = __builtin_bit_cast(bf16x8, w);
#pragma unroll
                for (int dt = 0; dt < 4; ++dt) o[g][dt] = mfma16(vf[dt][sl], pf, o[g][dt]);
            }
        }
    }
}

__device__ __forceinline__ void na_issue(LAS unsigned char* img, int w4, const bf16_t* kb, const bf16_t* vb, unsigned koff, unsigned voff) {
    if (w4 < 2) {
        const char* base = (const char*)kb + (size_t)(4096 * w4); LAS unsigned char* dst = img + w4 * 4096;
#pragma unroll
        for (int i = 0; i < 4; ++i) __builtin_amdgcn_global_load_lds((const unsigned*)(base + (512 * (i >> 1) + 64 * (i & 1)) + (size_t)koff), (LAS unsigned*)(dst + i * 1024), 16, 0, 0);
    } else {
        const char* base = (const char*)vb + (size_t)(2048 * (w4 - 2)); LAS unsigned char* dst = img + 8192 + (w4 - 2) * 4096;
#pragma unroll
        for (int i = 0; i < 4; ++i) __builtin_amdgcn_global_load_lds((const unsigned*)(base + (1024 * (i >> 1) + 4096 * (i & 1)) + (size_t)voff), (LAS unsigned*)(dst + i * 1024), 16, 0, 0);
    }
}
__device__ __forceinline__ void na_unit(int b, int h, int rg, int wave, int lane, unsigned char* ws, LAS const float* rpbS, LAS unsigned char* ldsb) {
    const bf16_t* NQ = (const bf16_t*)(ws + WS_NQ); const bf16_t* NK = (const bf16_t*)(ws + WS_NK); const bf16_t* NVT = (const bf16_t*)(ws + WS_NVT);
    const int r = lane & 15, q = lane >> 4;
    const int row = rg * 8 + wave;
    const int r0 = min(max(row - 4, 0), 56);
    const int umin = min(max(rg * 8 - 4, 0), 56);
    const size_t qtok = (size_t)b * 4096 + (size_t)row * 64;
    const bf16_t* KH = NK + ((size_t)((b * 8 + h) * 4096)) * 64;
    const bf16_t* KC = NK + (size_t)ML * 512 + ((size_t)((b * 8 + h) * 256)) * 64;
    const bf16_t* VH = NVT + ((size_t)((b * 8 + h) * 128)) * 2048;
    const bf16_t* VC = NVT + TL_LAT + ((size_t)((b * 8 + h) * 8)) * 2048;
    const unsigned koff = (unsigned)(((8 * (r >> 2) + (r & 3)) * 64 + 8 * q) * 2), voff = (unsigned)((r * 32 + 8 * q) * 2);
    LAS bf16x8* qlds = (LAS bf16x8*)(ldsb + wave * 8192) + lane;
    LAS unsigned char* imgs = ldsb + 65536;
    const int slot_w = wave >> 2, w4 = wave & 3;
    {
        const int ka = umin + ((0 - umin) & 7); const int kr = min(ka + 8 * slot_w, 63);
        na_issue(imgs + slot_w * 16384, w4, KH + (size_t)kr * 4096, VH + (size_t)kr * 4096, koff, voff);
    }
#pragma unroll
    for (int g = 0; g < 4; ++g)
#pragma unroll
        for (int kh = 0; kh < 2; ++kh) qlds[(g * 2 + kh) * 64] = *(const bf16x8*)((const char*)(NQ + ((size_t)((b * 8 + h) * 4096 + row * 64)) * 64) + ((16 * g) * 128 + kh * 64) + (size_t)(unsigned)((r * 64 + 8 * q) * 2));
    f32x4 o[4][4]; float mrow[4], lsum[4];
#pragma unroll
    for (int g = 0; g < 4; ++g) { mrow[g] = -1e30f; lsum[g] = 0.f;
#pragma unroll
        for (int dt = 0; dt < 4; ++dt) o[g][dt] = (f32x4){0.f, 0.f, 0.f, 0.f}; }
    unsigned long long vmask = 0ull;
#pragma unroll
    for (int g = 0; g < 4; ++g)
#pragma unroll
        for (int t = 0; t < 4; ++t) if (navalid(g, t)) {
#pragma unroll
            for (int j = 0; j < 4; ++j) {
                const int kc = 32 * (t >> 1) + 8 * q + 4 * (t & 1) + j, qc = 16 * g + r, c0 = min(max(qc - 8, 0), 48);
                if (kc >= c0 && kc < c0 + 16) vmask |= 1ull << (napidx(g, t) * 4 + j);
            }
        }
    const int lanebase = 63 + 8 * q - r;
#define NA_FRONT(n)                                                                                                                                   \
        asm volatile("s_waitcnt vmcnt(0)" ::: "memory");                                       \
        __syncthreads();                                                    \
        LAS unsigned char* cur = imgs + ((n) & 1) * 32768;                                                                                          \
        if ((n) + 1 < 12) {                                                                                  \
            LAS unsigned char* nxt = imgs + (((n) + 1) & 1) * 32768 + slot_w * 16384;                                                              \
            if ((n) + 1 < 8) { const int ka_ = umin + (((n) + 1 - umin) & 7); const int kr_ = min(ka_ + 8 * slot_w, 63); na_issue(nxt, w4, KH + (size_t)kr_ * 4096, VH + (size_t)kr_ * 4096, koff, voff); } \
            else if (slot_w == 0) { const int cs_ = (n) + 1 - 8; na_issue(nxt, w4, KC + (size_t)cs_ * 4096, VC + (size_t)cs_ * 4096, koff, voff); }  \
        }
#define NA_READ(slot)                                                                                                                                  \
        LAS const bf16x8* im = (LAS const bf16x8*)(cur + (slot) * 16384) + lane;                                                                    \
        bf16x8 kf[4][2], vf[4][2];                                                                                                                    \
        _Pragma("unroll") for (int t = 0; t < 4; ++t) _Pragma("unroll") for (int kh = 0; kh < 2; ++kh) kf[t][kh] = im[(t * 2 + kh) * 64];       \
        _Pragma("unroll") for (int dt = 0; dt < 4; ++dt) _Pragma("unroll") for (int s2 = 0; s2 < 2; ++s2) vf[dt][s2] = im[(8 + dt * 2 + s2) * 64];
#pragma unroll 1
    for (int n = 0; n < 8; ++n) {
        NA_FRONT(n)
        const int ka = umin + ((n - umin) & 7), kw = r0 + ((n - r0) & 7);
        const int myslot = (kw == ka) ? 0 : 1, ridx = kw - row + 7;
        NA_READ(myslot)
        na_step<true>(o, qlds, mrow, lsum, kf, vf, rpbS + ridx * 128 + lanebase, vmask);
    }
#pragma unroll 1
    for (int n = 8; n < 12; ++n) {
        NA_FRONT(n)
        NA_READ(0)
        na_step<false>(o, qlds, mrow, lsum, kf, vf, rpbS, 0ull);
    }
#undef NA_FRONT
#undef NA_READ
    int lane2 = lane; asm volatile("" : "+v"(lane2));
    const unsigned ooff = (unsigned)(((lane2 & 15) * 512 + 4 * (lane2 >> 4)) * 2);
    char* YNA = (char*)((bf16_t*)(ws + WS_YNA) + qtok * 512 + h * 64);
#pragma unroll
    for (int g = 0; g < 4; ++g) {
        float l = lsum[g]; l += __shfl_xor(l, 16); l += __shfl_xor(l, 32);
        const float inv = frcp(l);
#pragma unroll
        for (int dt = 0; dt < 4; ++dt) {
            u32x2 w; w.x = cvt_pk_bf16(o[g][dt][0] * inv, o[g][dt][1] * inv); w.y = cvt_pk_bf16(o[g][dt][2] * inv, o[g][dt][3] * inv);
            *(u32x2*)(YNA + ((16 * g) * 1024 + 32 * dt) + (size_t)ooff) = w;
        }
    }
}

__device__ __forceinline__ bf16x8 scale8(bf16x8 v, const float (&w)[8]) {
    const u32x4 u = __builtin_bit_cast(u32x4, v); u32x4 o;
    o.x = cvt_pk_bf16(bf_lo(u.x) * w[0], bf_hi(u.x) * w[1]); o.y = cvt_pk_bf16(bf_lo(u.y) * w[2], bf_hi(u.y) * w[3]);
    o.z = cvt_pk_bf16(bf_lo(u.z) * w[4], bf_hi(u.z) * w[5]); o.w = cvt_pk_bf16(bf_lo(u.w) * w[6], bf_hi(u.w) * w[7]);
    return __builtin_bit_cast(bf16x8, o);
}
__device__ __forceinline__ void state_unit(int it, int lane, unsigned char* ws, const float* dlog) {
    const int cc = it % NCH, bh = it / NCH, h = bh & 7;
    const int r = lane & 15, q = lane >> 4;
    const size_t tb0 = (cc < 2) ? (TL_LAT + ((size_t)(bh * 8 + 4 * cc)) * 2048) : (((size_t)(bh * 128 + 4 * (cc - 2))) * 2048);
    const bf16_t* VT = (const bf16_t*)(ws + WS_RVT) + tb0;
    const bf16_t* KT = (const bf16_t*)(ws + WS_KTF) + tb0;
    const float lgf = lg2_decay(dlog[h]), lgb = lg2_decay(dlog[8 + h]);
    const f32x4 zero = {0.f, 0.f, 0.f, 0.f};
    f32x4 af[4][4], ab[4][4];
#pragma unroll
    for (int a = 0; a < 4; ++a)
#pragma unroll
        for (int c = 0; c < 4; ++c) { af[a][c] = zero; ab[a][c] = zero; }
#pragma unroll
    for (int ks = 0; ks < 4; ++ks) {
        bf16x8 kq[4], vv[4];
#pragma unroll
        for (int a = 0; a < 4; ++a) { kq[a] = *(const bf16x8*)(KT + (ks * 2048 + (16 * a + r) * 32 + 8 * q)); vv[a] = *(const bf16x8*)(VT + (ks * 2048 + (16 * a + r) * 32 + 8 * q)); }
        float wf[8], wb[8];
#pragma unroll
        for (int e = 0; e < 8; ++e) { const int jl = 32 * ks + 8 * q + e; wf[e] = fexp2(lgf * (float)(127 - jl)); wb[e] = fexp2(lgb * (float)jl); }
#pragma unroll
        for (int c = 0; c < 4; ++c) {
            const bf16x8 vf = scale8(vv[c], wf), vb = scale8(vv[c], wb);
#pragma unroll
            for (int a = 0; a < 4; ++a) { af[a][c] = mfma16(kq[a], vf, af[a][c]); ab[a][c] = mfma16(kq[a], vb, ab[a][c]); }
        }
    }
    float* S = (float*)(ws + WS_SB) + ((size_t)(bh * NCH + cc) * 2) * 4096;
#pragma unroll
    for (int c = 0; c < 4; ++c)
#pragma unroll
        for (int a = 0; a < 4; ++a) { *(f32x4*)(S + (16 * c + r) * 64 + 16 * a + 4 * q) = af[a][c]; *(f32x4*)(S + 4096 + (16 * c + r) * 64 + 16 * a + 4 * q) = ab[a][c]; }
}

__device__ __forceinline__ unsigned long long scan_pack(f32x4 a) { return (unsigned long long)cvt_pk_bf16(a[0], a[1]) | ((unsigned long long)cvt_pk_bf16(a[2], a[3]) << 32); }
__device__ __forceinline__ void scan_item(int it, unsigned char* ws, const float* dlog) {
    const int wit = __builtin_amdgcn_readfirstlane(it >> 6), ln = it & 63;
    const int bh = wit >> 5, dir = (wit >> 4) & 1, dv = ((wit & 15) << 2) | (ln >> 4), i2 = ln & 15, h = bh & 7;
    const float G = fexp2(lg2_decay(dlog[dir * 8 + h]) * 128.f);
    const char* S = (const char*)((const float*)(ws + WS_SB) + ((size_t)(bh * NCH) * 2 + dir) * 4096);
    char* R = (char*)((bf16_t*)(ws + WS_RB) + ((size_t)(bh * 32) * 2 + dir) * 4096);
    const unsigned soff = (unsigned)((dv * 64 + 4 * i2) * 4), roff = (unsigned)((dv * 64 + 4 * i2) * 2);
    f32x4 a[NCH - 1];
    if (dir == 0) {
#pragma unroll
        for (int k = 0; k < NCH - 1; ++k) a[k] = *(const f32x4*)(S + (size_t)k * 32768 + (size_t)soff);
    } else {
#pragma unroll
        for (int k = 0; k < NCH - 1; ++k) { const int cc = (k == 0 ? 1 : (k == 1 ? 0 : 35 - k)); a[k] = *(const f32x4*)(S + (size_t)cc * 32768 + (size_t)soff); }
    }
    f32x4 s0 = a[0];
    s0 = G * s0 + a[1];
    if (dir == 0) {
        *(unsigned long long*)(R + (size_t)roff) = scan_pack(s0);
#pragma unroll
        for (int k = 2; k < NCH - 1; ++k) { s0 = G * s0 + a[k]; *(unsigned long long*)(R + (size_t)(k - 1) * 16384 + (size_t)roff) = scan_pack(s0); }
    } else {
        *(unsigned long long*)(R + (size_t)31 * 16384 + (size_t)roff) = scan_pack(s0);
#pragma unroll
        for (int k = 2; k < NCH - 1; ++k) { s0 = G * s0 + a[k]; *(unsigned long long*)(R + (size_t)(32 - k) * 16384 + (size_t)roff) = scan_pack(s0); }
    }
}

__device__ __forceinline__ void ret_unit(int u, int wv, int lane, unsigned char* ws, const float* dlog, LAS unsigned char* img) {
    const int c = u & 31, bh = u >> 5, b = bh >> 3, h = bh & 7;
    const int r = lane & 15, q = lane >> 4;
    const size_t tok0 = (size_t)b * 4096 + 128 * c;
    const int i0 = 32 * wv + r;
    const size_t hm0 = ((size_t)(bh * 4096 + 128 * c)) * 64;
    const char* qb = (const char*)((const bf16_t*)(ws + WS_RQ) + hm0 + (32 * wv) * 64);
    const char* kb = (const char*)((const bf16_t*)(ws + WS_RK) + hm0);
    const char* vb = (const char*)((const bf16_t*)(ws + WS_RVT) + ((size_t)(bh * 128 + 4 * c)) * 2048);
    const char* rb = (const char*)((const bf16_t*)(ws + WS_RB) + ((size_t)(bh * 32 + c) * 2) * 4096);
    const char* gb = (const char*)((const bf16_t*)(ws + WS_RG) + hm0 + (32 * wv) * 64);
    const unsigned qoff = (unsigned)((r * 64 + 8 * q) * 2), koff = (unsigned)(((8 * (r >> 2) + (r & 3)) * 64 + 8 * q) * 2);
    const unsigned voff = (unsigned)((r * 32 + 8 * q) * 2), roff = (unsigned)((r * 64 + 8 * q) * 2), goff = (unsigned)((r * 64 + 4 * q) * 2), yoff = (unsigned)((r * 512 + 4 * q) * 2);
#pragma unroll
    for (int i = 0; i < 4; ++i) {
        const int t = 2 * wv + (i >> 1), kh = i & 1;
        __builtin_amdgcn_global_load_lds((const unsigned*)(kb + ((32 * (t >> 1) + 4 * (t & 1)) * 128 + kh * 64) + (size_t)koff), (LAS unsigned*)(img + (t * 2 + kh) * 1024), 16, 0, 0);
        __builtin_amdgcn_global_load_lds((const unsigned*)(vb + (1024 * wv + 4096 * i) + (size_t)voff), (LAS unsigned*)(img + 16384 + (wv * 4 + i) * 1024), 16, 0, 0);
        const int dir = wv >> 1, dt = 2 * (wv & 1) + (i >> 1);
        __builtin_amdgcn_global_load_lds((const unsigned*)(rb + (dir * 8192 + (16 * dt) * 128 + kh * 64) + (size_t)roff), (LAS unsigned*)(img + 32768 + ((dir * 4 + dt) * 2 + kh) * 1024), 16, 0, 0);
    }
    bf16x8 qf[2][2];
#pragma unroll
    for (int nt = 0; nt < 2; ++nt)
#pragma unroll
        for (int kh = 0; kh < 2; ++kh) qf[nt][kh] = *(const bf16x8*)(qb + (nt * 2048 + kh * 64) + (size_t)qoff);
    u32x2 gv[2][4];
#pragma unroll
    for (int nt = 0; nt < 2; ++nt)
#pragma unroll
        for (int dt = 0; dt < 4; ++dt) gv[nt][dt] = *(const u32x2*)(gb + (nt * 2048 + 32 * dt) + (size_t)goff);
    const float lgf = lg2_decay(dlog[h]), lgb = lg2_decay(dlog[8 + h]);
    asm volatile("s_waitcnt vmcnt(0)" ::: "memory");
    __syncthreads();
    LAS const bf16x8* im = (LAS const bf16x8*)img + lane;
    const f32x4 zero = {0.f, 0.f, 0.f, 0.f};
    bf16x8 pf[2][4];
#pragma unroll
    for (int s = 0; s < 4; ++s) {
        bf16x8 kf[2][2];
#pragma unroll
        for (int tb = 0; tb < 2; ++tb)
#pragma unroll
            for (int kh = 0; kh < 2; ++kh) kf[tb][kh] = im[((2 * s + tb) * 2 + kh) * 64];
#pragma unroll
        for (int nt = 0; nt < 2; ++nt) {
            unsigned pw[4];
#pragma unroll
            for (int tb = 0; tb < 2; ++tb) {
                f32x4 sc = mfma16(kf[tb][0], qf[nt][0], zero); sc = mfma16(kf[tb][1], qf[nt][1], sc);
                float p[4];
#pragma unroll
                for (int j = 0; j < 4; ++j) { const int d = (i0 + 16 * nt) - (32 * s + 8 * q + 4 * tb + j); const float w = (d >= 0) ? fexp2(lgf * (float)d) : fexp2(lgb * (float)(-d)); p[j] = sc[j] * w; }
                pw[2 * tb] = cvt_pk_bf16(p[0], p[1]); pw[2 * tb + 1] = cvt_pk_bf16(p[2], p[3]);
            }
            u32x4 w; w.x = pw[0]; w.y = pw[1]; w.z = pw[2]; w.w = pw[3];
            pf[nt][s] = __builtin_bit_cast(bf16x8, w);
        }
    }
    char* yb = (char*)((bf16_t*)(ws + WS_YRET) + (tok0 + 32 * wv) * 512 + h * 64);
    f32x4 o[2][4];
#pragma unroll
    for (int dt = 0; dt < 4; ++dt) {
        bf16x8 vf[4], rf[2], rk[2];
#pragma unroll
        for (int s = 0; s < 4; ++s) vf[s] = im[(16 + dt * 4 + s) * 64];
#pragma unroll
        for (int kh = 0; kh < 2; ++kh) { rf[kh] = im[(32 + dt * 2 + kh) * 64]; rk[kh] = im[(32 + (4 + dt) * 2 + kh) * 64]; }
#pragma unroll
        for (int nt = 0; nt < 2; ++nt) {
            const int i = i0 + 16 * nt;
            const float wf = fexp2(lgf * (float)(i + 1)), wb = fexp2(lgb * (float)(128 - i));
            f32x4 a = zero;
#pragma unroll
            for (int s = 0; s < 4; ++s) a = mfma16(vf[s], pf[nt][s], a);
            f32x4 cf = mfma16(rf[0], qf[nt][0], zero); cf = mfma16(rf[1], qf[nt][1], cf);
            f32x4 cb = mfma16(rk[0], qf[nt][0], zero); cb = mfma16(rk[1], qf[nt][1], cb);
#pragma unroll
            for (int j = 0; j < 4; ++j) a[j] += wf * cf[j] + wb * cb[j];
            o[nt][dt] = a;
        }
    }
#pragma unroll
    for (int nt = 0; nt < 2; ++nt) {
        float ss = 0.f;
#pragma unroll
        for (int dt = 0; dt < 4; ++dt)
#pragma unroll
            for (int j = 0; j < 4; ++j) ss += o[nt][dt][j] * o[nt][dt][j];
        ss += __shfl_xor(ss, 16); ss += __shfl_xor(ss, 32);
        const float rinv = rsqrtf(ss * (1.f / 64.f) + EPSN);
#pragma unroll
        for (int dt = 0; dt < 4; ++dt) {
            const u32x2 g = gv[nt][dt];
            const float g0 = bf_lo(g.x), g1 = bf_hi(g.x), g2 = bf_lo(g.y), g3 = bf_hi(g.y);
            const float y0 = o[nt][dt][0] * rinv * g0 * frcp(1.f + fexp2(-g0 * LOG2E)), y1 = o[nt][dt][1] * rinv * g1 * frcp(1.f + fexp2(-g1 * LOG2E));
            const float y2 = o[nt][dt][2] * rinv * g2 * frcp(1.f + fexp2(-g2 * LOG2E)), y3 = o[nt][dt][3] * rinv * g3 * frcp(1.f + fexp2(-g3 * LOG2E));
            u32x2 w; w.x = cvt_pk_bf16(y0, y1); w.y = cvt_pk_bf16(y2, y3);
            *(u32x2*)(yb + (nt * 16384 + 32 * dt) + (size_t)yoff) = w;
        }
    }
    __syncthreads();
}

#define XB_TMO      128
#define XB_XCNT(j)  (256  + 64 * (j))
#define XB_XSUB(j)  (1280 + 64 * (j))
#define XB_XGEN(j)  (2304 + 64 * (j))
#define XB_TOP      3328
#define XB_TOPGEN   3392
#define XCD_BAR_WORDS 3456
#define XB_SPIN_CAP (1u << 18)

__device__ __forceinline__ unsigned xb_ld(unsigned* p)              { return __hip_atomic_load(p, __ATOMIC_RELAXED, __HIP_MEMORY_SCOPE_AGENT); }
__device__ __forceinline__ unsigned xb_add(unsigned* p, unsigned v) { return __hip_atomic_fetch_add(p, v, __ATOMIC_RELAXED, __HIP_MEMORY_SCOPE_AGENT); }
__device__ __forceinline__ unsigned xb_xcc_id() { return (unsigned)__builtin_amdgcn_s_getreg((3 << 11) | 20) & 0xFu; }
#define XB_SPIN(cond, bar) do { unsigned _sp = 0; while (cond) { __builtin_amdgcn_s_sleep(1); \
    if ((++_sp & 255u) == 0u) { if (xb_ld(&(bar)[XB_TMO])) break; if (_sp > XB_SPIN_CAP) { atomicAdd(&(bar)[XB_TMO], 1u); break; } } } } while (0)

struct XcdBarrier {
    unsigned* bar; unsigned x;
    volatile LAS unsigned* st;
};

__device__ __forceinline__ XcdBarrier xcd_barrier_post(unsigned* bar, volatile LAS unsigned* st) {
    XcdBarrier b; b.bar = bar; b.x = xb_xcc_id(); b.st = st;
    if (threadIdx.x == 0) (void)xb_add(&bar[XB_XCNT(b.x)], 1u);
    return b;
}
__device__ __forceinline__ void xcd_barrier_complete(unsigned* bar, unsigned x, unsigned& nloc, unsigned& nx) {
    const unsigned G = gridDim.x * gridDim.y * gridDim.z;
    unsigned sum, cnt, mine, sp = 0u;
    for (;;) {
        sum = 0u; cnt = 0u; mine = 0u;
#pragma unroll
        for (unsigned j = 0; j < 16; ++j) { const unsigned c = xb_ld(&bar[XB_XCNT(j)]); sum += c; cnt += (c > 0u) ? 1u : 0u; mine = (j == x) ? c : mine; }
        if (sum == G) break;
        __builtin_amdgcn_s_sleep(1);
        if ((++sp & 255u) == 0u) { if (xb_ld(&bar[XB_TMO])) break; if (sp > XB_SPIN_CAP) { atomicAdd(&bar[XB_TMO], 1u); break; } }
    }
    nloc = mine > 0u ? mine : 1u; nx = cnt > 0u ? cnt : 1u;
}

__device__ __forceinline__ void xcd_barrier(const XcdBarrier& b) {
    asm volatile("s_waitcnt vmcnt(0)" ::: "memory");
    __syncthreads();
    if (threadIdx.x == 0) {
        unsigned* bar = b.bar;
        __builtin_amdgcn_s_waitcnt(0);
        unsigned nloc = b.st[0], nx = b.st[1];
        if (nloc == 0u) { xcd_barrier_complete(bar, b.x, nloc, nx); b.st[0] = nloc; b.st[1] = nx; }
        const unsigned old = xb_add(&bar[XB_XSUB(b.x)], 1u);
        const unsigned gen = old / nloc;
        if (old + 1u == (gen + 1u) * nloc) {
            __builtin_amdgcn_fence(__ATOMIC_RELEASE, "agent");
            asm volatile("s_waitcnt vmcnt(0)" ::: "memory");
            const unsigned og = xb_add(&bar[XB_TOP], 1u);
            const unsigned tg = og / nx;
            if (og + 1u == (tg + 1u) * nx) xb_add(&bar[XB_TOPGEN], 1u);
            else XB_SPIN(xb_ld(&bar[XB_TOPGEN]) == tg, bar);
            __builtin_amdgcn_fence(__ATOMIC_ACQUIRE, "agent");
            xb_add(&bar[XB_XGEN(b.x)], 1u);
            asm volatile("s_waitcnt vmcnt(0)" ::: "memory");
        } else {
            XB_SPIN(xb_ld(&bar[XB_XGEN(b.x)]) == gen, bar);
            __builtin_amdgcn_fence(__ATOMIC_ACQUIRE, "agent");
            asm volatile("s_waitcnt vmcnt(0)" ::: "memory");
        }
    }
    __syncthreads();
}

__device__ __forceinline__ int lane_of(int tid) { int t = tid; asm volatile("" : "+v"(t)); return t & 63; }
struct Args { const float* in[18]; float* outp; unsigned char* wsp; int ph_lo, ph_hi; };
constexpr int NPH = 13;

__global__ void __launch_bounds__(512, 2) mk_fwd(Args a) {
    extern __shared__ __attribute__((aligned(16))) unsigned char lds_raw[];
    LAS unsigned char* lds = (LAS unsigned char*)lds_raw;
    cg::grid_group grid = cg::this_grid();
    const int tid = threadIdx.x, wave = __builtin_amdgcn_readfirstlane(tid >> 6);
#define lane (lane_of(tid))
    const int G = gridDim.x, bx = blockIdx.x;
    if (tid < 64) ((LAS unsigned*)(lds + 131072))[tid] = 0u;
    __syncthreads();
    XcdBarrier xbar = xcd_barrier_post((unsigned*)(a.wsp + WS_BAR), (volatile LAS unsigned*)(lds + 131072));
    const int gw = bx * 8 + wave, NGW = G * 8;
#define ws (a.wsp)
#define XIN (a.in[0])
#define cvec (a.in[1])
#define ctx (a.in[2])
#define cctx (a.in[3])
#define w_ada (a.in[4])
#define b_ada (a.in[5])
#define g_pre_mix (a.in[6])
#define g_post_mix (a.in[7])
#define g_pre_ffn (a.in[8])
#define g_post_ffn (a.in[9])
#define dlog (a.in[11])
#define rpb (a.in[13])
#define MOD ((float*)(a.wsp + WS_MOD))
#define cosT ((float*)(a.wsp + WS_COS))
#define sinT ((float*)(a.wsp + WS_SIN))
#define out (a.outp)
    const int lo = a.ph_lo, hi = a.ph_hi;
#ifndef REP_MASK
#define REP_MASK 0
#endif
#ifndef SYNC_REP
#define SYNC_REP 1
#endif
#define TILE_RC(row, j, ln) ((((size_t)(((row) >> 8) * 4 + (j))) << 16) + (size_t)((((row) & 255) * 256) + 4 * (ln)))
#define IN(k) (lo <= (k) && (k) < hi)
#ifndef REP_CNT
#define REP_CNT 2
#endif
#define REPS(k) (((REP_MASK >> (k)) & 1) ? REP_CNT : 1)
#define SEAM(k) do { if (IN(k) && IN((k) + 1)) { for (int _s = 0; _s < SYNC_REP; ++_s) { if (lo < 0) grid.sync();     xcd_barrier(xbar); } } } while (0)

    if (IN(0)) for (int _rep = 0; _rep < REPS(0); ++_rep) { if (_rep) xcd_barrier(xbar);
        for (int it = bx; it < 192; it += G) ada_item(it, cvec, cctx, w_ada, b_ada, MOD, (LAS float*)lds, tid);
        if (bx == G - 1) {
            for (int idx = tid; idx < 1024; idx += 512) { const int pos = idx >> 4, f = idx & 15; const float inv = exp2f(-(float)f * (13.287712379549449f / 16.f)); const float ang = (float)pos * inv; cosT[idx] = __cosf(ang); sinT[idx] = __sinf(ang); }
        }
        __syncthreads();
        LAS float* scr = (LAS float*)(lds + wave * 8704);
        constexpr int I0 = 16 * 176, I1 = 8 * 32, I2 = 8 * 32, I3 = 16 * 32, I4 = 16 * 128, I5 = 64 * 32;
        const int nconv = (G == 256) ? I0 : (I0 + I1 + I2 + I3 + I4 + I5);
        for (int it = gw; it < nconv; it += NGW) {
            int rr = it;
            if (rr < I0) { conv_item(a.in[10], 1024, INC, 0, ws, scr, rr, lane); continue; } rr -= I0;
            if (rr < I1) { conv_item(a.in[12], 512, 1024, 1, ws, scr, rr, lane); continue; } rr -= I1;
            if (rr < I2) { conv_item(a.in[14], 512, 1024, 2, ws, scr, rr, lane); continue; } rr -= I2;
            if (rr < I3) { conv_item(a.in[15], 1024, 1024, 3, ws, scr, rr, lane); continue; } rr -= I3;
            if (rr < I4) { conv_item(a.in[16], 1024, 4096, 4, ws, scr, rr, lane); continue; } rr -= I4;
            conv_item(a.in[17], 4096, 1024, 5, ws, scr, rr, lane);
        }
    }
    SEAM(0);
    if (IN(1)) for (int _rep = 0; _rep < REPS(1); ++_rep) { if (_rep) xcd_barrier(xbar);
        bf16_t* XN = (bf16_t*)(ws + WS_XN);
        const int ln = lane;
        f32x4 nx[4];
        { const int row = gw; const float* src = (row < ML) ? (XIN + (size_t)row * 1024) : (ctx + (size_t)(row - ML) * 1024);
#pragma unroll
          for (int j = 0; j < 4; ++j) nx[j] = *(const f32x4*)(src + 4 * ln + 256 * j); }
        for (int row = gw; row < MT; row += NGW) {
            f32x4 v[4];
#pragma unroll
            for (int j = 0; j < 4; ++j) v[j] = nx[j];
            const int nrow = row + NGW;
            if (nrow < MT) { const float* src = (nrow < ML) ? (XIN + (size_t)nrow * 1024) : (ctx + (size_t)(nrow - ML) * 1024);
#pragma unroll
                for (int j = 0; j < 4; ++j) nx[j] = *(const f32x4*)(src + 4 * ln + 256 * j); }
            const float* mod = (row < ML) ? (MOD + (row >> 12) * 6144) : (MOD + 8 * 6144);
            float ss = 0.f;
#pragma unroll
            for (int j = 0; j < 4; ++j) ss += (v[j][0] * v[j][0] + v[j][1] * v[j][1]) + (v[j][2] * v[j][2] + v[j][3] * v[j][3]);
            const float rinv = rsqrtf(wave_sum(ss) * (1.f / 1024.f) + EPSN);
#pragma unroll
            for (int j = 0; j < 4; ++j) {
                const int c = 4 * ln + 256 * j;
                const f32x4 gg = *(const f32x4*)(g_pre_mix + c), s1 = *(const f32x4*)(mod + 1024 + c), s0 = *(const f32x4*)(mod + c);
                f32x4 hh;
#pragma unroll
                for (int e = 0; e < 4; ++e) hh[e] = v[j][e] * rinv * gg[e] * (1.f + s1[e]) + s0[e];
                u32x2 w; w.x = cvt_pk_bf16(hh[0], hh[1]); w.y = cvt_pk_bf16(hh[2], hh[3]);
                *(u32x2*)(XN + (size_t)row * 1024 + c) = w;
            }
        }
    }
    SEAM(1);
    if (IN(2)) for (int _rep = 0; _rep < REPS(2); ++_rep) { if (_rep) xcd_barrier(xbar);
        SchedInproj S{(const char*)(ws + WS_XN), (const char*)(ws + WS_WIN1), (const char*)(ws + WS_WIN2), G, bx};
        LAS float* ltab = (LAS float*)(lds + 132096);
        for (int idx = tid; idx < 1024; idx += 512) { ltab[idx] = cosT[idx]; ltab[1024 + idx] = sinT[idx]; }
        __syncthreads();
        EpiInproj E{ws, (bf16_t*)out, ltab, ltab + 1024, dlog};
        pg8::gemm_phase<EpiInproj, SchedInproj, true, true>(lds, 1024, S, E);
        if (G == 256 && bx >= 64) {
            LAS float* scr = (LAS float*)(lds + wave * 8704);
            constexpr int I1 = 8 * 32, I2 = 8 * 32, I3 = 16 * 32, I4 = 16 * 128, I5 = 64 * 32;
            for (int it = (bx - 64) * 8 + wave; it < I1 + I2 + I3 + I4 + I5; it += 192 * 8) {
                int rr = it;
                if (rr < I1) { conv_item(a.in[12], 512, 1024, 1, ws, scr, rr, lane); continue; } rr -= I1;
                if (rr < I2) { conv_item(a.in[14], 512, 1024, 2, ws, scr, rr, lane); continue; } rr -= I2;
                if (rr < I3) { conv_item(a.in[15], 1024, 1024, 3, ws, scr, rr, lane); continue; } rr -= I3;
                if (rr < I4) { conv_item(a.in[16], 1024, 4096, 4, ws, scr, rr, lane); continue; } rr -= I4;
                conv_item(a.in[17], 4096, 1024, 5, ws, scr, rr, lane);
            }
        }
    }
    SEAM(2);
    if (IN(3)) for (int _rep = 0; _rep < REPS(3); ++_rep) { if (_rep) xcd_barrier(xbar);
        for (int it = gw; it < 64 * NCH; it += NGW) state_unit(it, lane, ws, dlog);
        LAS float* rpbS = (LAS float*)(lds + 132096);
        const int vcu = (G % 8 == 0) ? ((bx % 8) * (G / 8) + bx / 8) : bx;
        for (int u = vcu; u < 512; u += G) {
            const int b = u >> 6, h = (u >> 3) & 7, rg = u & 7;
            __syncthreads();
            int t2 = tid; asm volatile("" : "+v"(t2));
            for (int idx = t2; idx < 15 * 128; idx += 512) { const int ri = idx >> 7, ci = (idx & 127) - 48; const float bv = (ci >= 0 && ci < 31) ? rpb[(h * 15 + ri) * 31 + ci] * LOG2E : 0.f;
                rpbS[idx] = bv; rpbS[15 * 128 + idx] = (ci >= 7 && ci <= 22) ? bv : -1e30f; }
            __syncthreads();
            na_unit(b, h, rg, wave, lane, ws, rpbS, lds);
        }
    }
    SEAM(3);
    if (IN(4)) for (int _rep = 0; _rep < REPS(4); ++_rep) { if (_rep) xcd_barrier(xbar);
        for (int it = bx * 512 + tid; it < 64 * 2 * 1024; it += G * 512) scan_item(it, ws, dlog);
    }
    SEAM(4);
    if (IN(5)) for (int _rep = 0; _rep < REPS(5); ++_rep) { if (_rep) xcd_barrier(xbar);
        LAS unsigned char* img = lds + (wave >> 2) * 49152;
        if (G == 256) { for (int k = 0; k < 4; ++k) ret_unit(bx * 8 + 2 * k + (wave >> 2), wave & 3, lane, ws, dlog, img); }
        else { for (int up = bx; up < 1024; up += G) ret_unit(2 * up + (wave >> 2), wave & 3, lane, ws, dlog, img); }
    }
    SEAM(5);
    if (IN(6)) for (int _rep = 0; _rep < REPS(6); ++_rep) { if (_rep) xcd_barrier(xbar);
        SchedSimple S{(const char*)(ws + WS_YRET), (const char*)(ws + WS_WR), 128, 4, G, bx, 0};
        EpiMerge<0> E{(const bf16_t*)out, (bf16_t*)(ws + WS_Z)};
        pg8::gemm_phase<EpiMerge<0>, SchedSimple, true, true>(lds, 512, S, E);
    }
    SEAM(6);
    if (IN(7)) for (int _rep = 0; _rep < REPS(7); ++_rep) { if (_rep) xcd_barrier(xbar);
        SchedSimple S{(const char*)(ws + WS_YNA), (const char*)(ws + WS_WN), 128, 4, G, bx, 0};
        EpiMerge<1> E{(const bf16_t*)out, (bf16_t*)(ws + WS_Z)};
        pg8::gemm_phase<EpiMerge<1>, SchedSimple, true, true>(lds, 512, S, E);
    }
    SEAM(7);
    if (IN(8)) for (int _rep = 0; _rep < REPS(8); ++_rep) { if (_rep) xcd_barrier(xbar);
        SchedSimple S{(const char*)(ws + WS_Z), (const char*)(ws + WS_WO), 128, 4, G, bx, 0};
        EpiPlain<0, 1> E{(bf16_t*)(ws + WS_Y), 1024};
        pg8::gemm_phase<EpiPlain<0, 1>, SchedSimple, true, true>(lds, 1024, S, E);
    }
    SEAM(8);
    if (IN(9)) for (int _rep = 0; _rep < REPS(9); ++_rep) { if (_rep) xcd_barrier(xbar);
        const bf16_t* Y = (const bf16_t*)(ws + WS_Y); bf16_t* H2 = (bf16_t*)(ws + WS_H2);
        const int ln = lane;
        f32x4 nx[4]; u32x2 ny[4];
#pragma unroll
        for (int j = 0; j < 4; ++j) { const int c = 4 * ln + 256 * j; ny[j] = *(const u32x2*)(Y + TILE_RC(gw, j, ln)); nx[j] = *(const f32x4*)(XIN + (size_t)gw * 1024 + c); }
        for (int row = gw; row < ML; row += NGW) {
            const float* mod = MOD + (row >> 12) * 6144;
            f32x4 y[4], xv[4]; float ss = 0.f;
#pragma unroll
            for (int j = 0; j < 4; ++j) {
                const u32x2 w = ny[j];
                y[j][0] = bf_lo(w.x); y[j][1] = bf_hi(w.x); y[j][2] = bf_lo(w.y); y[j][3] = bf_hi(w.y);
                xv[j] = nx[j];
                ss += (y[j][0] * y[j][0] + y[j][1] * y[j][1]) + (y[j][2] * y[j][2] + y[j][3] * y[j][3]);
            }
            const int nrow = row + NGW;
            if (nrow < ML) {
#pragma unroll
                for (int j = 0; j < 4; ++j) { const int c = 4 * ln + 256 * j; ny[j] = *(const u32x2*)(Y + TILE_RC(nrow, j, ln)); nx[j] = *(const f32x4*)(XIN + (size_t)nrow * 1024 + c); }
            }
            const float r1 = rsqrtf(wave_sum(ss) * (1.f / 1024.f) + EPSN);
            float ss2 = 0.f;
#pragma unroll
            for (int j = 0; j < 4; ++j) {
                const int c = 4 * ln + 256 * j;
                const f32x4 gp = *(const f32x4*)(g_post_mix + c), gt = *(const f32x4*)(mod + 2048 + c);
#pragma unroll
                for (int e = 0; e < 4; ++e) { xv[j][e] = xv[j][e] + gt[e] * (y[j][e] * r1 * gp[e]); ss2 += xv[j][e] * xv[j][e]; }
            }
            const float r2 = rsqrtf(wave_sum(ss2) * (1.f / 1024.f) + EPSN);
#pragma unroll
            for (int j = 0; j < 4; ++j) {
                const int c = 4 * ln + 256 * j;
                const f32x4 gg = *(const f32x4*)(g_pre_ffn + c), s0 = *(const f32x4*)(mod + 3072 + c), s1 = *(const f32x4*)(mod + 4096 + c);
                f32x4 hh;
#pragma unroll
                for (int e = 0; e < 4; ++e) hh[e] = xv[j][e] * r2 * gg[e] * (1.f + s1[e]) + s0[e];
                u32x2 w; w.x = cvt_pk_bf16(hh[0], hh[1]); w.y = cvt_pk_bf16(hh[2], hh[3]);
                *(u32x2*)(H2 + ((((size_t)((row >> 8) * 16 + (c >> 6))) * 256 + (row & 255)) * 64 + (c & 63))) = w;
            }
        }
    }
    SEAM(9);
    if (IN(10)) for (int _rep = 0; _rep < REPS(10); ++_rep) { if (_rep) xcd_barrier(xbar);
        SchedSimple S{(const char*)(ws + WS_H2), (const char*)(ws + WS_W1), 128, 16, G, bx, 0};
        EpiPlain<1, 2> E{(bf16_t*)(ws + WS_U), 4096};
        pg8::gemm_phase<EpiPlain<1, 2>, SchedSimple, true, true, true>(lds, 1024, S, E);
    }
    SEAM(10);
    if (IN(11)) for (int _rep = 0; _rep < REPS(11); ++_rep) { if (_rep) xcd_barrier(xbar);
        SchedSimple S{(const char*)(ws + WS_U), (const char*)(ws + WS_W2), 128, 4, G, bx, 0};
        EpiPlain<0, 1> E{(bf16_t*)(ws + WS_H2), 1024};
        pg8::gemm_phase<EpiPlain<0, 1>, SchedSimple, true, true, true>(lds, 4096, S, E);
    }
    SEAM(11);
    if (IN(12)) for (int _rep = 0; _rep < REPS(12); ++_rep) { if (_rep) xcd_barrier(xbar);
        const bf16_t* F = (const bf16_t*)(ws + WS_H2); const bf16_t* Y = (const bf16_t*)(ws + WS_Y);
        const int ln = lane;
        f32x4 nx[4]; u32x2 ny[4], nf[4];
#pragma unroll
        for (int j = 0; j < 4; ++j) { const int c = 4 * ln + 256 * j; nf[j] = *(const u32x2*)(F + TILE_RC(gw, j, ln)); ny[j] = *(const u32x2*)(Y + TILE_RC(gw, j, ln)); nx[j] = *(const f32x4*)(XIN + (size_t)gw * 1024 + c); }
        for (int row = gw; row < ML; row += NGW) {
            const float* mod = MOD + (row >> 12) * 6144;
            f32x4 y[4], f[4], xv[4]; float ss = 0.f, sf = 0.f;
#pragma unroll
            for (int j = 0; j < 4; ++j) {
                const u32x2 w = ny[j], v = nf[j];
                y[j][0] = bf_lo(w.x); y[j][1] = bf_hi(w.x); y[j][2] = bf_lo(w.y); y[j][3] = bf_hi(w.y);
                f[j][0] = bf_lo(v.x); f[j][1] = bf_hi(v.x); f[j][2] = bf_lo(v.y); f[j][3] = bf_hi(v.y);
                xv[j] = nx[j];
                ss += (y[j][0] * y[j][0] + y[j][1] * y[j][1]) + (y[j][2] * y[j][2] + y[j][3] * y[j][3]);
                sf += (f[j][0] * f[j][0] + f[j][1] * f[j][1]) + (f[j][2] * f[j][2] + f[j][3] * f[j][3]);
            }
            const int nrow = row + NGW;
            if (nrow < ML) {
#pragma unroll
                for (int j = 0; j < 4; ++j) { const int c = 4 * ln + 256 * j; nf[j] = *(const u32x2*)(F + TILE_RC(nrow, j, ln)); ny[j] = *(const u32x2*)(Y + TILE_RC(nrow, j, ln)); nx[j] = *(const f32x4*)(XIN + (size_t)nrow * 1024 + c); }
            }
#pragma unroll
            for (int o2 = 1; o2 < 64; o2 <<= 1) { ss += __shfl_xor(ss, o2); sf += __shfl_xor(sf, o2); }
            const float r1 = rsqrtf(ss * (1.f / 1024.f) + EPSN), r2 = rsqrtf(sf * (1.f / 1024.f) + EPSN);
#pragma unroll
            for (int j = 0; j < 4; ++j) {
                const int c = 4 * ln + 256 * j;
                const f32x4 gp = *(const f32x4*)(g_post_mix + c), gt = *(const f32x4*)(mod + 2048 + c);
                const f32x4 gq = *(const f32x4*)(g_post_ffn + c), gu = *(const f32x4*)(mod + 5120 + c);
#pragma unroll
                for (int e = 0; e < 4; ++e) { const float x1 = xv[j][e] + gt[e] * (y[j][e] * r1 * gp[e]); xv[j][e] = x1 + gu[e] * (f[j][e] * r2 * gq[e]); }
                *(f32x4*)(out + (size_t)row * 1024 + c) = xv[j];
            }
        }
    }
#undef IN
#undef SEAM
#undef lane
#undef ws
#undef XIN
#undef cvec
#undef ctx
#undef cctx
#undef w_ada
#undef b_ada
#undef g_pre_mix
#undef g_post_mix
#undef g_pre_ffn
#undef g_post_ffn
#undef dlog
#undef rpb
#undef MOD
#undef cosT
#undef sinT
#undef out
}

#ifndef MK_MULTI
#define MK_MULTI 0
#endif
extern "C" void kernel_launch(void* const* d_in, const int* in_sizes, int n_in, void* d_out, int out_size, void* d_ws, size_t ws_size, hipStream_t stream) {
    static int grid = 0;
    if (grid == 0) {
        if (n_in != 18 || out_size != ML * DM || ws_size < WS_END) { fprintf(stderr, "kernel_launch: unexpected problem (n_in %d out %d ws %zu)\n", n_in, out_size, ws_size); grid = -1; return; }
        int dev = 0, cus = 0, per_cu = 0;
        if (hipGetDevice(&dev) != hipSuccess || hipDeviceGetAttribute(&cus, hipDeviceAttributeMultiprocessorCount, dev) != hipSuccess) { grid = -1; return; }
        if (hipFuncSetAttribute((const void*)mk_fwd, hipFuncAttributeMaxDynamicSharedMemorySize, LDS_BYTES) != hipSuccess) { fprintf(stderr, "kernel_launch: hipFuncSetAttribute failed\n"); grid = -1; return; }
        if (hipOccupancyMaxActiveBlocksPerMultiprocessor(&per_cu, (const void*)mk_fwd, 512, LDS_BYTES) != hipSuccess || per_cu < 1) { fprintf(stderr, "kernel_launch: occupancy query says %d\n", per_cu); (void)hipGetLastError(); grid = -1; return; }
        grid = cus;
    }
    if (grid < 0) return;
    if (hipMemsetAsync((char*)d_ws + WS_BAR, 0, 16384, stream) != hipSuccess) { fprintf(stderr, "kernel_launch: memset failed\n"); return; }
    Args a{};
    for (int i = 0; i < 18; ++i) a.in[i] = (const float*)d_in[i];
    a.outp = (float*)d_out; a.wsp = (unsigned char*)d_ws;
#if MK_MULTI
    for (int p = 0; p < NPH; ++p) { a.ph_lo = p; a.ph_hi = p + 1; hipLaunchKernelGGL(mk_fwd, dim3(grid), dim3(512), LDS_BYTES, stream, a); }
#else
    a.ph_lo = 0; a.ph_hi = NPH;
    void* args[] = {&a};
    hipError_t e = hipLaunchCooperativeKernel((const void*)mk_fwd, dim3(grid), dim3(512), args, LDS_BYTES, stream);
    if (e != hipSuccess) fprintf(stderr, "kernel_launch: cooperative launch failed: %s (grid %d)\n", hipGetErrorString(e), grid);
#endif
}
```

```cpp
#include <hip/hip_runtime.h>
#include <hip/hip_cooperative_groups.h>
#include <cstdio>
#include <cstdint>
namespace cg = cooperative_groups;

#define PG8_LAS __attribute__((address_space(3)))
#define LAS __attribute__((address_space(3)))
typedef unsigned short bf16_t;
typedef short bf16x8 __attribute__((ext_vector_type(8)));
typedef float f32x4 __attribute__((ext_vector_type(4)));
typedef unsigned u32x4 __attribute__((ext_vector_type(4)));
typedef unsigned u32x2 __attribute__((ext_vector_type(2)));

constexpr int NB = 8, SEQ = 4096, DM = 1024, CTXL = 256, NH = 8, DH = 64, DFF = 4096, INC = 5632;
constexpr int ML = NB * SEQ, MC = NB * CTXL, MT = ML + MC;
constexpr int NCH = 34;
constexpr float LOG2E = 1.4426950408889634f;
constexpr float QSCALE = 0.125f * LOG2E;
constexpr float EPSN = 1e-6f;

constexpr size_t MiB = 1u << 20;
constexpr size_t WS_MOD = 0;
constexpr size_t WS_COS = 256 * 1024, WS_SIN = WS_COS + 4096;
constexpr size_t WS_BAR = 512 * 1024;
constexpr size_t WS_WIN1 = 2 * MiB;
constexpr size_t WS_WIN2 = 11 * MiB;
constexpr size_t WS_WR = 14 * MiB, WS_WN = 15 * MiB;
constexpr size_t WS_WO = 16 * MiB;
constexpr size_t WS_W1 = 18 * MiB;
constexpr size_t WS_W2 = 26 * MiB;
constexpr size_t WS_XN = 34 * MiB;
constexpr size_t WS_SB = WS_XN, WS_H2 = WS_XN;
constexpr size_t WS_RQ = 102 * MiB, WS_RK = 134 * MiB, WS_RG = 166 * MiB, WS_NQ = 198 * MiB, WS_NK = 230 * MiB;
constexpr size_t WS_RB = WS_NK;
constexpr size_t WS_KTF = 264 * MiB, WS_KTB = 298 * MiB, WS_RVT = 332 * MiB, WS_NVT = 366 * MiB;
constexpr size_t WS_Z = WS_KTF;
constexpr size_t WS_Y = WS_RQ;
constexpr size_t WS_U = 166 * MiB;
constexpr size_t WS_F = WS_RQ;
constexpr size_t WS_YNA = 422 * MiB, WS_YRET = 454 * MiB;
constexpr size_t WS_END = 486 * MiB;
constexpr int LDS_BYTES = 147456;

__device__ __forceinline__ unsigned cvt_pk_bf16(float lo, float hi) { unsigned r; asm volatile("v_cvt_pk_bf16_f32 %0, %1, %2" : "=v"(r) : "v"(lo), "v"(hi)); return r; }
__device__ __forceinline__ float bf_lo(unsigned w) { return __builtin_bit_cast(float, w << 16); }
__device__ __forceinline__ float bf_hi(unsigned w) { return __builtin_bit_cast(float, w & 0xffff0000u); }
__device__ __forceinline__ float fexp2(float x) { return __builtin_amdgcn_exp2f(x); }
__device__ __forceinline__ float frcp(float x) { return __builtin_amdgcn_rcpf(x); }
__device__ __forceinline__ float wave_sum(float v) {
#pragma unroll
    for (int o = 1; o < 64; o <<= 1) v += __shfl_xor(v, o);
    return v;
}
__device__ __forceinline__ f32x4 mfma16(bf16x8 a, bf16x8 b, f32x4 c) { return __builtin_amdgcn_mfma_f32_16x16x32_bf16(a, b, c, 0, 0, 0); }
__device__ __forceinline__ float lg2_decay(float logit) {
    const float e = __expf(-logit);
    float l1p;
    if (e < 0.1f) l1p = e * (1.f - e * (0.5f - e * (0.33333334f - e * (0.25f - e * (0.2f - e * (0.16666667f - e * 0.14285715f))))));
    else l1p = __logf(1.f + e);
    return -l1p * LOG2E;
}

namespace pg8 {
constexpr int BM = 256, BK = 64, HALF = 128, HTB = HALF * BK * 2, STAGE_BYTES = 8 * HTB, NXCD = 8, WGM = 8;
__host__ __device__ __forceinline__ int lds_byte(int r, int c) { const int st = (r >> 4) * 2 + (c >> 5), rr = r & 15, cc = c & 31, ob = rr * 64 + cc * 2; return st * 1024 + (ob ^ (((ob >> 9) & 1) << 5)); }
__host__ __device__ __forceinline__ void stage_rc(int b, int& R, int& C) { const int st = b / 1024, sb = b % 1024, swz = sb ^ (((sb >> 9) & 1) << 5); R = (st >> 1) * 16 + swz / 64; C = (st & 1) * 32 + (swz % 64) / 2; }
__host__ __device__ __forceinline__ int perm32(int rho) { const int n = rho >> 4, i = rho & 15; return 8 * (i >> 2) + 4 * n + (i & 3); }
struct Unit { int pm, pn, kind; };
__device__ __forceinline__ void map_tile(int L, int nM, int nN, int& pm, int& pn) {
    const int nwg = nM * nN; int wgid = L;
    { const int q = nwg / NXCD, r = nwg % NXCD, xcd = wgid % NXCD, off = wgid / NXCD; wgid = (xcd < r ? xcd * (q + 1) : r * (q + 1) + (xcd - r) * q) + off; }
    const int nig = WGM * nN, gid = wgid / nig, fm = gid * WGM, gsz = (nM - fm) < WGM ? (nM - fm) : WGM;
    pm = fm + ((wgid % nig) % gsz); pn = (wgid % nig) / gsz;
}

template <class Epi, class Sched, bool ALIGN_EPI = false, bool SP2 = false, bool ABLK = false>
__device__ __forceinline__ void gemm_phase(PG8_LAS unsigned char* lds, const int K, const Sched& S, const Epi& E) {
    const int tid = threadIdx.x, wid = __builtin_amdgcn_readfirstlane(tid >> 6), lane = tid & 63, wr = wid >> 2, wc = wid & 3, fr = lane & 15, fq = lane >> 4;
    const int nt = K / BK;
    unsigned voffA[2], voffB[2];
#pragma unroll
    for (int i = 0; i < 2; ++i) { int R, C; stage_rc(tid * 16 + i * 8192, R, C); const int Rb = Epi::PERM ? ((R & ~31) + perm32(R & 31)) : R;
        voffA[i] = (unsigned)(R * (ABLK ? 64 : K) + C) * 2u; voffB[i] = (unsigned)(Rb * K + C) * 2u; }
    const size_t kstep = (size_t)(BK * 2);
    const size_t hstep = (size_t)HALF * K * 2;
    const size_t tstep = 2 * hstep;
    const size_t kstepA = ABLK ? (size_t)32768 : kstep, hstepA = ABLK ? (size_t)16384 : hstep;
    const unsigned ldsw = (unsigned)wid * 1024u;
    const int aoff = lds_byte(wr * 64 + fr, fq * 8), boff = lds_byte(wc * 32 + fr, fq * 8);
#define PG8_SA(b, h) (((b) * 2 + (h)) * HTB)
#define PG8_SB(b, h) ((4 + (b) * 2 + (h)) * HTB)
#define PG8_STAGE(bufoff, gbase, voff) do { _Pragma("unroll") for (int _i = 0; _i < 2; ++_i) \
        __builtin_amdgcn_global_load_lds((const unsigned*)((const char*)(gbase) + (voff)[_i]), (PG8_LAS unsigned*)(lds + (bufoff) + ldsw + _i * 8192), 16, 0, 0); } while (0)
#define PG8_LDA(dst, b, h) do { _Pragma("unroll") for (int m = 0; m < 4; ++m) _Pragma("unroll") for (int k = 0; k < 2; ++k) dst[m][k] = *(const PG8_LAS bf16x8*)(lds + PG8_SA(b, h) + aoff + m * 2048 + k * 1024); } while (0)
#define PG8_LDB(dst, b, h) do { _Pragma("unroll") for (int n = 0; n < 2; ++n) _Pragma("unroll") for (int k = 0; k < 2; ++k) dst[n][k] = *(const PG8_LAS bf16x8*)(lds + PG8_SB(b, h) + boff + n * 2048 + k * 1024); } while (0)
#define PG8_MMA(ai, bj, At, Bt) do { __builtin_amdgcn_s_setprio(1); _Pragma("unroll") for (int m = 0; m < 4; ++m) _Pragma("unroll") for (int n = 0; n < 2; ++n) _Pragma("unroll") for (int k = 0; k < 2; ++k) \
        acc[ai][bj][m][n] = __builtin_amdgcn_mfma_f32_16x16x32_bf16(Bt[n][k], At[m][k], acc[ai][bj][m][n], 0, 0, 0); __builtin_amdgcn_s_setprio(0); } while (0)
#define PG8_WAIT_V(n) asm volatile("s_waitcnt vmcnt(" #n ")" ::: "memory")
#define PG8_WAIT_L(n) asm volatile("s_waitcnt lgkmcnt(" #n ")" ::: "memory")
#define PG8_BAR __builtin_amdgcn_s_barrier()
#define PG8_SCHED __builtin_amdgcn_sched_barrier(0)
    Unit cur, nxt; int ui = 0;
    if (!S.next(0, cur)) return;
    f32x4 acc[2][2][4][2];
#pragma unroll
    for (int a = 0; a < 2; ++a)
#pragma unroll
        for (int b = 0; b < 2; ++b)
#pragma unroll
            for (int m = 0; m < 4; ++m)
#pragma unroll
                for (int n = 0; n < 2; ++n) acc[a][b][m][n] = (f32x4){0.f, 0.f, 0.f, 0.f};
    bf16x8 At[4][2], B0[2][2], B1[2][2];
    const char* cA; const char* cB; S.ptrs(cur, tstep, cA, cB);
    if constexpr (SP2) {
        PG8_STAGE(PG8_SB(0, 0), cB, voffB); PG8_STAGE(PG8_SB(0, 1), cB + hstep, voffB); PG8_STAGE(PG8_SA(0, 0), cA, voffA); PG8_STAGE(PG8_SA(0, 1), cA + hstepA, voffA);
        if (wr == 1) PG8_BAR;
        PG8_WAIT_V(2); PG8_BAR;
        PG8_STAGE(PG8_SB(1, 0), cB + kstep, voffB); PG8_STAGE(PG8_SA(1, 0), cA + kstepA, voffA); PG8_STAGE(PG8_SB(1, 1), cB + hstep + kstep, voffB);
        PG8_WAIT_V(6); PG8_BAR;
    } else {
        PG8_STAGE(PG8_SB(0, 0), cB, voffB); PG8_STAGE(PG8_SA(0, 0), cA, voffA); PG8_STAGE(PG8_SB(0, 1), cB + hstep, voffB); PG8_STAGE(PG8_SA(0, 1), cA + hstepA, voffA);
        if (wr == 1) PG8_BAR;
        PG8_WAIT_V(4); PG8_BAR;
        PG8_STAGE(PG8_SB(1, 0), cB + kstep, voffB); PG8_STAGE(PG8_SA(1, 0), cA + kstepA, voffA); PG8_STAGE(PG8_SB(1, 1), cB + hstep + kstep, voffB);
        PG8_WAIT_V(6); PG8_BAR;
    }
    for (;;) {
        const bool has_next = S.next(ui + 1, nxt);
        const char* nA = cA; const char* nB = cB; if (has_next) S.ptrs(nxt, tstep, nA, nB);
        for (int t = 0; t < nt; t += 2) {
            const bool last = (t == nt - 2);
            const char* a1 = cA + (size_t)(t + 1) * kstepA;
            const char* a2 = last ? nA : cA + (size_t)(t + 2) * kstepA; const char* b2 = last ? nB : cB + (size_t)(t + 2) * kstep;
            const char* a3 = a2 + kstepA; const char* b3 = b2 + kstep;
            if constexpr (SP2) {
            PG8_LDB(B0, 0, 0); PG8_LDB(B1, 0, 1); PG8_SCHED; PG8_LDA(At, 0, 0); PG8_STAGE(PG8_SA(1, 1), a1 + hstepA, voffA);
            PG8_WAIT_V(8); PG8_WAIT_L(0); PG8_BAR; PG8_MMA(0, 0, At, B0); PG8_MMA(0, 1, At, B1); PG8_BAR; PG8_SCHED;
            PG8_LDA(At, 0, 1); PG8_STAGE(PG8_SB(0, 0), b2, voffB); PG8_STAGE(PG8_SB(0, 1), b2 + hstep, voffB); PG8_STAGE(PG8_SA(0, 0), a2, voffA);
            PG8_WAIT_V(8); PG8_WAIT_L(0); PG8_BAR; PG8_MMA(1, 0, At, B0); PG8_MMA(1, 1, At, B1); PG8_BAR; PG8_SCHED;
            PG8_LDB(B0, 1, 0); PG8_LDB(B1, 1, 1); PG8_SCHED; PG8_LDA(At, 1, 0); PG8_STAGE(PG8_SA(0, 1), a2 + hstepA, voffA);
            PG8_WAIT_V(8); PG8_WAIT_L(0); PG8_BAR; PG8_MMA(0, 0, At, B0); PG8_MMA(0, 1, At, B1); PG8_BAR; PG8_SCHED;
            PG8_LDA(At, 1, 1); PG8_STAGE(PG8_SB(1, 0), b3, voffB); PG8_STAGE(PG8_SB(1, 1), b3 + hstep, voffB); PG8_STAGE(PG8_SA(1, 0), a3, voffA);
            PG8_WAIT_V(8); PG8_WAIT_L(0); PG8_BAR; PG8_MMA(1, 0, At, B0); PG8_MMA(1, 1, At, B1); PG8_BAR; PG8_SCHED;
            } else {
            PG8_LDB(B0, 0, 0); PG8_SCHED; PG8_LDA(At, 0, 0); PG8_STAGE(PG8_SA(1, 1), a1 + hstepA, voffA);
            PG8_WAIT_L(8); PG8_BAR; PG8_WAIT_L(0); PG8_MMA(0, 0, At, B0); PG8_BAR; PG8_SCHED;
            PG8_LDB(B1, 0, 1); PG8_STAGE(PG8_SB(0, 0), b2, voffB);
            PG8_BAR; PG8_WAIT_L(0); PG8_MMA(0, 1, At, B1); PG8_BAR;
            PG8_LDA(At, 0, 1); PG8_STAGE(PG8_SA(0, 0), a2, voffA);
            PG8_BAR; PG8_WAIT_L(0); PG8_MMA(1, 0, At, B0); PG8_BAR; PG8_SCHED;
            PG8_STAGE(PG8_SB(0, 1), b2 + hstep, voffB);
            PG8_WAIT_V(6); PG8_BAR; PG8_MMA(1, 1, At, B1); PG8_BAR;
            PG8_LDB(B0, 1, 0); PG8_SCHED; PG8_LDA(At, 1, 0); PG8_STAGE(PG8_SA(0, 1), a2 + hstepA, voffA);
            PG8_WAIT_L(8); PG8_BAR; PG8_WAIT_L(0); PG8_MMA(0, 0, At, B0); PG8_BAR; PG8_SCHED;
            PG8_LDB(B1, 1, 1); PG8_STAGE(PG8_SB(1, 0), b3, voffB);
            PG8_BAR; PG8_WAIT_L(0); PG8_MMA(0, 1, At, B1); PG8_BAR;
            PG8_LDA(At, 1, 1); PG8_STAGE(PG8_SA(1, 0), a3, voffA);
            PG8_BAR; PG8_WAIT_L(0); PG8_MMA(1, 0, At, B0); PG8_BAR; PG8_SCHED;
            PG8_STAGE(PG8_SB(1, 1), b3 + hstep, voffB);
            PG8_WAIT_V(6); PG8_BAR; PG8_MMA(1, 1, At, B1); PG8_BAR;
            }
        }
        if constexpr (ALIGN_EPI) { if (wr == 0) PG8_BAR; }
        E(acc, cur, wr, wc, fr, fq);
        if (!has_next) break;
#pragma unroll
        for (int a = 0; a < 2; ++a)
#pragma unroll
            for (int b = 0; b < 2; ++b)
#pragma unroll
                for (int m = 0; m < 4; ++m)
#pragma unroll
                    for (int n = 0; n < 2; ++n) acc[a][b][m][n] = (f32x4){0.f, 0.f, 0.f, 0.f};
        cur = nxt; cA = nA; cB = nB; ++ui;
        if constexpr (ALIGN_EPI) { if (wr == 1) PG8_BAR; }
    }
    PG8_WAIT_V(0);
    if constexpr (!ALIGN_EPI) { if (wr == 0) PG8_BAR; }
    PG8_BAR;
#undef PG8_SA
#undef PG8_SB
#undef PG8_STAGE
#undef PG8_LDA
#undef PG8_LDB
#undef PG8_MMA
#undef PG8_WAIT_V
#undef PG8_WAIT_L
#undef PG8_BAR
#undef PG8_SCHED
}
}

struct SchedSimple {
    const char* A; const char* B; int nM, nN, G, c, kind;
    __device__ __forceinline__ bool next(int i, pg8::Unit& u) const { const int L = i * G + c; if (L >= nM * nN) return false; pg8::map_tile(L, nM, nN, u.pm, u.pn); u.kind = kind; return true; }
    __device__ __forceinline__ void ptrs(const pg8::Unit& u, size_t tstep, const char*& a, const char*& b) const { a = A + (size_t)u.pm * tstep; b = B + (size_t)u.pn * tstep; }
};
struct SchedInproj {
    const char* XN; const char* W1; const char* W2; int G, c;
    static constexpr int N0 = 128 * 18, N1 = 4 * 136, N2 = 32;
    __device__ __forceinline__ bool next(int i, pg8::Unit& u) const {
        const int L = i * G + c;
        if (L < N0) { pg8::map_tile(L, 128, 18, u.pm, u.pn); u.kind = 0; return true; }
        if (L < N0 + N1) { pg8::map_tile(L - N0, 4, 136, u.pm, u.pn); u.kind = 1; return true; }
        if (L < N0 + N1 + N2) { const int l = L - N0 - N1; u.pm = 128 + (l & 7); u.pn = ((l >> 3) < 2) ? (2 + (l >> 3)) : (6 + (l >> 3)); u.kind = 0; return true; }
        return false;
    }
    __device__ __forceinline__ void ptrs(const pg8::Unit& u, size_t tstep, const char*& a, const char*& b) const {
        if (u.kind == 0) { a = XN + (size_t)u.pm * tstep; b = W1 + (size_t)u.pn * tstep; }
        else { a = W2 + (size_t)u.pm * tstep; b = XN + (size_t)u.pn * tstep; }
    }
};

typedef const f32x4 (&AccRef)[2][2][4][2];
__device__ __forceinline__ u32x4 pack8(f32x4 v0, f32x4 v1) { u32x4 w; w.x = cvt_pk_bf16(v0[0], v0[1]); w.y = cvt_pk_bf16(v0[2], v0[3]); w.z = cvt_pk_bf16(v1[0], v1[1]); w.w = cvt_pk_bf16(v1[2], v1[3]); return w; }

constexpr size_t TL_LAT = (size_t)64 * 128 * 2048;
__device__ __forceinline__ size_t tl_off(int tok, int hh, int d) {
    if (tok < ML) { const int b = tok >> 12, n = tok & 4095; return ((size_t)(((b * 8 + hh) * 128 + (n >> 5)) * 64 + d)) * 32 + (n & 31); }
    const int t = tok - ML, b = t >> 8, j = t & 255; return TL_LAT + ((size_t)(((b * 8 + hh) * 8 + (j >> 5)) * 64 + d)) * 32 + (j & 31);
}
struct EpiInproj {
    static constexpr bool PERM = true;
    unsigned char* ws; bf16_t* gates; LAS const float* cosT; LAS const float* sinT; const float* dlog;
    __device__ __forceinline__ void rowmajor(AccRef acc, const pg8::Unit& u, int wr, int wc, int fr, int fq) const {
        const int ct = u.pn; bf16_t* base; int ld, colt, typ;
        if (ct < 10) { typ = ct >> 1; base = (bf16_t*)(ws + WS_RQ + (size_t)typ * 32 * MiB); ld = 512; colt = (ct & 1) * 256; }
        else { typ = 5; base = gates; ld = 2048; colt = (ct - 10) * 256; }
        const int row0 = u.pm * 256 + wr * 64 + fr, col0 = colt + wc * 32 + 8 * fq;
#pragma unroll
        for (int ai = 0; ai < 2; ++ai)
#pragma unroll
            for (int m = 0; m < 4; ++m) {
                const int row = row0 + ai * 128 + m * 16; const int nl = row & 4095, rowpos = nl >> 6, colpos = nl & 63;
#pragma unroll
                for (int bj = 0; bj < 2; ++bj) {
                    const int col = col0 + bj * 128; f32x4 v0 = acc[ai][bj][m][0], v1 = acc[ai][bj][m][1];
                    if (typ == 1 && row >= ML) { v0 = v0 * 0.125f; v1 = v1 * 0.125f; }
                    else if (typ <= 1) {
                        const int i0 = (col & 63) >> 1, pos = (i0 < 16) ? rowpos : colpos, f0 = i0 & 15;
                        const f32x4 cs = *(LAS const f32x4*)(cosT + pos * 16 + f0), sn = *(LAS const f32x4*)(sinT + pos * 16 + f0);
                        const float sc = (typ == 1) ? 0.125f : 1.f;
                        f32x4 a, b;
                        a[0] = (v0[0] * cs[0] - v0[1] * sn[0]) * sc; a[1] = (v0[0] * sn[0] + v0[1] * cs[0]) * sc;
                        a[2] = (v0[2] * cs[1] - v0[3] * sn[1]) * sc; a[3] = (v0[2] * sn[1] + v0[3] * cs[1]) * sc;
                        b[0] = (v1[0] * cs[2] - v1[1] * sn[2]) * sc; b[1] = (v1[0] * sn[2] + v1[1] * cs[2]) * sc;
                        b[2] = (v1[2] * cs[3] - v1[3] * sn[3]) * sc; b[3] = (v1[2] * sn[3] + v1[3] * cs[3]) * sc;
                        v0 = a; v1 = b;
                    } else if (typ == 3) { v0 = v0 * QSCALE; v1 = v1 * QSCALE; }
                    else if (typ == 5) {
#pragma unroll
                        for (int e = 0; e < 4; ++e) { v0[e] = frcp(1.f + fexp2(-v0[e] * LOG2E)); v1[e] = frcp(1.f + fexp2(-v1[e] * LOG2E)); }
                    }
                    if (typ == 1) {
                        const int hh = col >> 6;
                        const bool odd = (fr & 1) != 0;
                        const size_t to = tl_off(row & ~1, hh, (col & 63) + (odd ? 4 : 0));
                        unsigned* tf = (unsigned*)((bf16_t*)(ws + WS_KTF) + to);
#pragma unroll
                        for (int e = 0; e < 4; ++e) {
                            const float mine = odd ? v1[e] : v0[e], send = odd ? v0[e] : v1[e];
                            const float rf = __builtin_bit_cast(float, __builtin_amdgcn_update_dpp(0, __builtin_bit_cast(int, send), 0xB1, 0xF, 0xF, false));
                            tf[e * 16] = odd ? cvt_pk_bf16(rf, mine) : cvt_pk_bf16(mine, rf);
                        }
                        if (row >= ML) continue;
                    }
                    size_t doff;
                    if (typ == 5) doff = ((size_t)((row >> 8) * 8 + (col >> 8)) << 16) + (size_t)((row & 255) * 256 + (col & 255));
                    else if (row < ML) doff = ((size_t)(((row >> 12) * 8 + (col >> 6)) * 4096 + (row & 4095))) * 64 + (col & 63);
                    else doff = (size_t)ML * 512 + ((size_t)((((row - ML) >> 8) * 8 + (col >> 6)) * 256 + ((row - ML) & 255))) * 64 + (col & 63);
                    *(u32x4*)(base + doff) = pack8(v0, v1);
                }
            }
    }
    __device__ __forceinline__ void transposed(AccRef acc, const pg8::Unit& u, int wr, int wc, int fr, int fq) const {
        const int region = u.pm >> 1;
        const int tok0 = u.pn * 256 + wc * 32 + 8 * fq;
        bf16_t* base = (bf16_t*)(ws + (region == 0 ? WS_RVT : WS_NVT));
        const int rowb = (u.pm & 1) * 256 + wr * 64 + fr;
#pragma unroll
        for (int ai = 0; ai < 2; ++ai)
#pragma unroll
            for (int m = 0; m < 4; ++m) {
                const int row = rowb + ai * 128 + m * 16;
#pragma unroll
                for (int bj = 0; bj < 2; ++bj) *(u32x4*)(base + tl_off(tok0 + bj * 128, row >> 6, row & 63)) = pack8(acc[ai][bj][m][0], acc[ai][bj][m][1]);
            }
    }
    __device__ __forceinline__ void operator()(AccRef acc, const pg8::Unit& u, int wr, int wc, int fr, int fq) const {
        if (u.kind == 0) rowmajor(acc, u, wr, wc, fr, fq); else transposed(acc, u, wr, wc, fr, fq);
    }
};

template <int TERM> struct EpiMerge {
    static constexpr bool PERM = true;
    const bf16_t* gates; bf16_t* Z;
    __device__ __forceinline__ void operator()(AccRef acc, const pg8::Unit& u, int wr, int wc, int fr, int fq) const {
        const int row0 = u.pm * 256 + wr * 64 + fr, col0 = u.pn * 256 + wc * 32 + 8 * fq;
#pragma unroll
        for (int ai = 0; ai < 2; ++ai)
#pragma unroll
            for (int m = 0; m < 4; ++m) {
                const int row = row0 + ai * 128 + m * 16;
#pragma unroll
                for (int bj = 0; bj < 2; ++bj) {
                    const int col = col0 + bj * 128;
                    const u32x4 g = *(const u32x4*)(gates + (((size_t)((row >> 8) * 8 + TERM * 4 + (col >> 8))) << 16) + (size_t)((row & 255) * 256 + (col & 255)));
                    f32x4 v0 = acc[ai][bj][m][0], v1 = acc[ai][bj][m][1];
                    v0[0] *= bf_lo(g.x); v0[1] *= bf_hi(g.x); v0[2] *= bf_lo(g.y); v0[3] *= bf_hi(g.y);
                    v1[0] *= bf_lo(g.z); v1[1] *= bf_hi(g.z); v1[2] *= bf_lo(g.w); v1[3] *= bf_hi(g.w);
                    bf16_t* zp = Z + ((((size_t)((row >> 8) * 16 + (col >> 6))) * 256 + (row & 255)) * 64 + (col & 63));
                    if (TERM == 1) {
                        const u32x4 z = *(const u32x4*)zp;
                        v0[0] += bf_lo(z.x); v0[1] += bf_hi(z.x); v0[2] += bf_lo(z.y); v0[3] += bf_hi(z.y);
                        v1[0] += bf_lo(z.z); v1[1] += bf_hi(z.z); v1[2] += bf_lo(z.w); v1[3] += bf_hi(z.w);
                    }
                    *(u32x4*)zp = pack8(v0, v1);
                }
            }
    }
};

template <int ACT, int TILED = 0> struct EpiPlain {
    static constexpr bool PERM = true;
    bf16_t* O; int ld;
    __device__ __forceinline__ void operator()(AccRef acc, const pg8::Unit& u, int wr, int wc, int fr, int fq) const {
        const int row0 = u.pm * 256 + wr * 64 + fr, col0 = u.pn * 256 + wc * 32 + 8 * fq;
#pragma unroll
        for (int ai = 0; ai < 2; ++ai)
#pragma unroll
            for (int m = 0; m < 4; ++m) {
                const int row = row0 + ai * 128 + m * 16;
#pragma unroll
                for (int bj = 0; bj < 2; ++bj) {
                    f32x4 v0 = acc[ai][bj][m][0], v1 = acc[ai][bj][m][1];
                    if (ACT == 1) {
#pragma unroll
                        for (int e = 0; e < 4; ++e) { const float a = fmaxf(v0[e], 0.f), b = fmaxf(v1[e], 0.f); v0[e] = a * a; v1[e] = b * b; }
                    }
                    const int col = col0 + bj * 128;
                    const size_t off = (TILED == 2) ? ((((size_t)((row >> 8) * (ld >> 6) + (col >> 6))) * 256 + (row & 255)) * 64 + (col & 63)) : (TILED == 1) ? ((((size_t)((row >> 8) * (ld >> 8) + (col >> 8))) << 16) + (size_t)((row & 255) * 256 + (col & 255))) : ((size_t)row * ld + col);
                    *(u32x4*)(O + off) = pack8(v0, v1);
                }
            }
    }
};

__device__ __forceinline__ void conv_item(const float* W, int K, int N, int mat, unsigned char* ws, LAS float* scr, int item, int lane) {
    const int nblk = N / 32, kb = item / nblk, nb = item % nblk, k0 = 64 * kb, n0 = 32 * nb;
#pragma unroll 8
    for (int i = 0; i < 32; ++i) { const int kk = 2 * i + (lane >> 5); scr[kk * 33 + (lane & 31)] = W[(size_t)(k0 + kk) * N + n0 + (lane & 31)]; }
    asm volatile("s_waitcnt vmcnt(0) lgkmcnt(0)" ::: "memory");
    const int c = lane & 7;
#pragma unroll
    for (int j = 0; j < 4; ++j) {
        const int n = (lane >> 3) + 8 * j; const LAS float* s = scr + (8 * c) * 33 + n;
        u32x4 o; o.x = cvt_pk_bf16(s[0 * 33], s[1 * 33]); o.y = cvt_pk_bf16(s[2 * 33], s[3 * 33]); o.z = cvt_pk_bf16(s[4 * 33], s[5 * 33]); o.w = cvt_pk_bf16(s[6 * 33], s[7 * 33]);
        const int gn = n0 + n;
        bf16_t* d0; bf16_t* d1 = nullptr;
        bf16_t* win1 = (bf16_t*)(ws + WS_WIN1); bf16_t* win2 = (bf16_t*)(ws + WS_WIN2);
        if (mat == 0) {
            if (gn < 1024) {
                const int which = gn >> 9, cc = gn & 511, hh = cc >> 6, d = cc & 63, p = (d < 32) ? 2 * d : 2 * (d - 32) + 1;
                d0 = win1 + (size_t)(which * 512 + hh * 64 + p) * 1024;
            } else if (gn < 1536) d0 = win2 + (size_t)(gn - 1024) * 1024;
            else if (gn < 2048) d0 = win1 + (size_t)(1024 + gn - 1536) * 1024;
            else if (gn < 2560) d0 = win1 + (size_t)(1536 + gn - 2048) * 1024;
            else if (gn < 3072) d0 = win1 + (size_t)(2048 + gn - 2560) * 1024;
            else if (gn < 3584) d0 = win2 + (size_t)(512 + gn - 3072) * 1024;
            else d0 = win1 + (size_t)(2560 + gn - 3584) * 1024;
        } else {
            const size_t off = (mat == 1) ? WS_WR : (mat == 2) ? WS_WN : (mat == 3) ? WS_WO : (mat == 4) ? WS_W1 : WS_W2;
            d0 = (bf16_t*)(ws + off) + (size_t)gn * K;
        }
        *(u32x4*)(d0 + k0 + 8 * c) = o;
        if (d1) *(u32x4*)(d1 + k0 + 8 * c) = o;
    }
    asm volatile("s_waitcnt lgkmcnt(0)" ::: "memory");
}

__device__ __forceinline__ void ada_item(int it, const float* cvec, const float* cctx, const float* w_ada, const float* b_ada, float* MOD, LAS float* lds, int tid) {
    LAS float* sl = lds;
    LAS float* red = lds + 9 * 1024;
    for (int idx = tid; idx < 9 * 1024; idx += 512) { const int bb = idx >> 10, k = idx & 1023; const float v = (bb < 8) ? cvec[bb * 1024 + k] : cctx[k]; sl[idx] = v * frcp(1.f + __expf(-v)); }
    __syncthreads();
    const int col = tid & 31, ks = tid >> 5, j0 = it * 32;
    float a0 = 0.f, a1 = 0.f, a2 = 0.f, a3 = 0.f, a4 = 0.f, a5 = 0.f, a6 = 0.f, a7 = 0.f, a8 = 0.f;
#pragma unroll 16
    for (int kk = 0; kk < 64; ++kk) {
        const int k = ks * 64 + kk; const float w = w_ada[(size_t)k * 6144 + j0 + col];
        a0 += sl[k] * w; a1 += sl[1024 + k] * w; a2 += sl[2048 + k] * w; a3 += sl[3072 + k] * w; a4 += sl[4096 + k] * w;
        a5 += sl[5120 + k] * w; a6 += sl[6144 + k] * w; a7 += sl[7168 + k] * w; a8 += sl[8192 + k] * w;
    }
    LAS float* rp = red + ks * 288 + col;
    rp[0] = a0; rp[32] = a1; rp[64] = a2; rp[96] = a3; rp[128] = a4; rp[160] = a5; rp[192] = a6; rp[224] = a7; rp[256] = a8;
    __syncthreads();
    if (tid < 288) { float s = 0.f;
#pragma unroll
        for (int q = 0; q < 16; ++q) s += red[q * 288 + tid];
        const int bb = tid >> 5, cc = tid & 31; MOD[bb * 6144 + j0 + cc] = s + b_ada[j0 + cc]; }
    __syncthreads();
}

__device__ __forceinline__ void modulate_row(const float* src, const float* g, const float* sh, const float* sc, bf16_t* dst, int lane) {
    f32x4 v[4]; float ss = 0.f;
#pragma unroll
    for (int j = 0; j < 4; ++j) { v[j] = *(const f32x4*)(src + 4 * lane + 256 * j); ss += (v[j][0] * v[j][0] + v[j][1] * v[j][1]) + (v[j][2] * v[j][2] + v[j][3] * v[j][3]); }
    const float rinv = rsqrtf(wave_sum(ss) * (1.f / 1024.f) + EPSN);
#pragma unroll
    for (int j = 0; j < 4; ++j) {
        const int c = 4 * lane + 256 * j;
        const f32x4 gg = *(const f32x4*)(g + c), s1 = *(const f32x4*)(sc + c), s0 = *(const f32x4*)(sh + c);
        f32x4 h;
#pragma unroll
        for (int e = 0; e < 4; ++e) h[e] = v[j][e] * rinv * gg[e] * (1.f + s1[e]) + s0[e];
        u32x2 w; w.x = cvt_pk_bf16(h[0], h[1]); w.y = cvt_pk_bf16(h[2], h[3]);
        *(u32x2*)(dst + c) = w;
    }
}

__host__ __device__ constexpr bool navalid(int g, int t) { return (g == 0) ? (t < 2) : (g == 3) ? (t >= 2) : true; }
__host__ __device__ constexpr int napidx(int g, int t) { int n = 0; for (int gg = 0; gg < 4; ++gg) for (int tt = 0; tt < 4; ++tt) { if (gg == g && tt == t) return n; if (navalid(gg, tt)) ++n; } return n; }

template <int T0, int T1>
__device__ __forceinline__ void na_kload(bf16x8 (&kf)[4][2], const char* kbase, unsigned koff) {
#pragma unroll
    for (int t = T0; t < T1; ++t)
#pragma unroll
        for (int kh = 0; kh < 2; ++kh) kf[t][kh] = *(const bf16x8*)(kbase + ((32 * (t >> 1) + 4 * (t & 1)) * 128 + kh * 64) + (size_t)koff);
}

template <bool LOCAL>
__device__ __forceinline__ void na_step(f32x4 (&o)[4][4], LAS const bf16x8* qlds, float (&mrow)[4], float (&lsum)[4], const bf16x8 (&kf)[4][2], const bf16x8 (&vf)[4][2],
                                        LAS const float* rpbrow, unsigned long long vmask_in) {
    unsigned vm_lo = (unsigned)vmask_in, vm_hi = (unsigned)(vmask_in >> 32);
    asm volatile("" : "+v"(vm_lo), "+v"(vm_hi));
    const f32x4 zero = {0.f, 0.f, 0.f, 0.f};
#pragma unroll
    for (int g = 0; g < 4; ++g) {
        f32x4 s[4];
        float mx = -1e30f;
        const bf16x8 q0 = qlds[(g * 2 + 0) * 64], q1 = qlds[(g * 2 + 1) * 64];
#pragma unroll
        for (int t = 0; t < 4; ++t) {
            if (!LOCAL || navalid(g, t)) {
                f32x4 a = mfma16(kf[t][0], q0, zero); a = mfma16(kf[t][1], q1, a);
                if (LOCAL) {
                    if (g == 1 || g == 2) {
#pragma unroll
                        for (int j = 0; j < 4; ++j) a[j] += rpbrow[15 * 128 + 32 * (t >> 1) + 4 * (t & 1) + j - 16 * g];
                    } else {
#pragma unroll
                        for (int j = 0; j < 4; ++j) {
                            const float bias = rpbrow[32 * (t >> 1) + 4 * (t & 1) + j - 16 * g];
                            const int bit = napidx(g, t) * 4 + j;
                            const bool ok = ((bit < 32 ? (vm_lo >> (bit & 31)) : (vm_hi >> (bit & 31))) & 1u) != 0u;
                            a[j] = ok ? (a[j] + bias) : -1e30f;
                        }
                    }
                }
                s[t] = a;
                mx = fmaxf(mx, fmaxf(fmaxf(a[0], a[1]), fmaxf(a[2], a[3])));
            } else s[t] = zero;
        }
        if (__any(mx > mrow[g] + 16.f)) {
            mx = fmaxf(mx, __shfl_xor(mx, 16)); mx = fmaxf(mx, __shfl_xor(mx, 32));
            const float mnew = fmaxf(mrow[g], mx), alpha = fexp2(mrow[g] - mnew); mrow[g] = mnew;
            lsum[g] = lsum[g] * alpha;
#pragma unroll
            for (int dt = 0; dt < 4; ++dt) o[g][dt] = o[g][dt] * alpha;
        }
        const float mref = mrow[g];
        float psum = 0.f;
#pragma unroll
        for (int t = 0; t < 4; ++t) if (!LOCAL || navalid(g, t)) {
#pragma unroll
            for (int j = 0; j < 4; ++j) { const float p = fexp2(s[t][j] - mref); psum += p; s[t][j] = p; }
        }
        lsum[g] += psum;
#pragma unroll
        for (int sl = 0; sl < 2; ++sl) {
            if (!LOCAL || navalid(g, 2 * sl)) {
                u32x4 w; w.x = cvt_pk_bf16(s[2 * sl][0], s[2 * sl][1]); w.y = cvt_pk_bf16(s[2 * sl][2], s[2 * sl][3]);
                w.z = cvt_pk_bf16(s[2 * sl + 1][0], s[2 * sl + 1][1]); w.w = cvt_pk_bf16(s[2 * sl + 1][2], s[2 * sl + 1][3]);
                const bf16x8 pf = __builtin_bit_cast(bf16x8, w);
#pragma unroll
                for (int dt = 0; dt < 4; ++dt) o[g][dt] = mfma16(vf[dt][sl], pf, o[g][dt]);
            }
        }
    }
}

__device__ __forceinline__ void na_issue(LAS unsigned char* img, int w4, const bf16_t* kb, const bf16_t* vb, unsigned koff, unsigned voff) {
    if (w4 < 2) {
        const char* base = (const char*)kb + (size_t)(4096 * w4); LAS unsigned char* dst = img + w4 * 4096;
#pragma unroll
        for (int i = 0; i < 4; ++i) __builtin_amdgcn_global_load_lds((const unsigned*)(base + (512 * (i >> 1) + 64 * (i & 1)) + (size_t)koff), (LAS unsigned*)(dst + i * 1024), 16, 0, 0);
    } else {
        const char* base = (const char*)vb + (size_t)(2048 * (w4 - 2)); LAS unsigned char* dst = img + 8192 + (w4 - 2) * 4096;
#pragma unroll
        for (int i = 0; i < 4; ++i) __builtin_amdgcn_global_load_lds((const unsigned*)(base + (1024 * (i >> 1) + 4096 * (i & 1)) + (size_t)voff), (LAS unsigned*)(dst + i * 1024), 16, 0, 0);
    }
}
__device__ __forceinline__ void na_unit(int b, int h, int rg, int wave, int lane, unsigned char* ws, LAS const float* rpbS, LAS unsigned char* ldsb) {
    const bf16_t* NQ = (const bf16_t*)(ws + WS_NQ); const bf16_t* NK = (const bf16_t*)(ws + WS_NK); const bf16_t* NVT = (const bf16_t*)(ws + WS_NVT);
    const int r = lane & 15, q = lane >> 4;
    const int row = rg * 8 + wave;
    const int r0 = min(max(row - 4, 0), 56);
    const int umin = min(max(rg * 8 - 4, 0), 56);
    const size_t qtok = (size_t)b * 4096 + (size_t)row * 64;
    const bf16_t* KH = NK + ((size_t)((b * 8 + h) * 4096)) * 64;
    const bf16_t* KC = NK + (size_t)ML * 512 + ((size_t)((b * 8 + h) * 256)) * 64;
    const bf16_t* VH = NVT + ((size_t)((b * 8 + h) * 128)) * 2048;
    const bf16_t* VC = NVT + TL_LAT + ((size_t)((b * 8 + h) * 8)) * 2048;
    const unsigned koff = (unsigned)(((8 * (r >> 2) + (r & 3)) * 64 + 8 * q) * 2), voff = (unsigned)((r * 32 + 8 * q) * 2);
    LAS bf16x8* qlds = (LAS bf16x8*)(ldsb + wave * 8192) + lane;
    LAS unsigned char* imgs = ldsb + 65536;
    const int slot_w = wave >> 2, w4 = wave & 3;
    {
        const int ka = umin + ((0 - umin) & 7); const int kr = min(ka + 8 * slot_w, 63);
        na_issue(imgs + slot_w * 16384, w4, KH + (size_t)kr * 4096, VH + (size_t)kr * 4096, koff, voff);
    }
#pragma unroll
    for (int g = 0; g < 4; ++g)
#pragma unroll
        for (int kh = 0; kh < 2; ++kh) qlds[(g * 2 + kh) * 64] = *(const bf16x8*)((const char*)(NQ + ((size_t)((b * 8 + h) * 4096 + row * 64)) * 64) + ((16 * g) * 128 + kh * 64) + (size_t)(unsigned)((r * 64 + 8 * q) * 2));
    f32x4 o[4][4]; float mrow[4], lsum[4];
#pragma unroll
    for (int g = 0; g < 4; ++g) { mrow[g] = -1e30f; lsum[g] = 0.f;
#pragma unroll
        for (int dt = 0; dt < 4; ++dt) o[g][dt] = (f32x4){0.f, 0.f, 0.f, 0.f}; }
    unsigned long long vmask = 0ull;
#pragma unroll
    for (int g = 0; g < 4; ++g)
#pragma unroll
        for (int t = 0; t < 4; ++t) if (navalid(g, t)) {
#pragma unroll
            for (int j = 0; j < 4; ++j) {
                const int kc = 32 * (t >> 1) + 8 * q + 4 * (t & 1) + j, qc = 16 * g + r, c0 = min(max(qc - 8, 0), 48);
                if (kc >= c0 && kc < c0 + 16) vmask |= 1ull << (napidx(g, t) * 4 + j);
            }
        }
    const int lanebase = 63 + 8 * q - r;
#define NA_FRONT(n)                                                                                                                                   \
        asm volatile("s_waitcnt vmcnt(0)" ::: "memory");                                       \
        __syncthreads();                                                    \
        LAS unsigned char* cur = imgs + ((n) & 1) * 32768;                                                                                          \
        if ((n) + 1 < 12) {                                                                                  \
            LAS unsigned char* nxt = imgs + (((n) + 1) & 1) * 32768 + slot_w * 16384;                                                              \
            if ((n) + 1 < 8) { const int ka_ = umin + (((n) + 1 - umin) & 7); const int kr_ = min(ka_ + 8 * slot_w, 63); na_issue(nxt, w4, KH + (size_t)kr_ * 4096, VH + (size_t)kr_ * 4096, koff, voff); } \
            else if (slot_w == 0) { const int cs_ = (n) + 1 - 8; na_issue(nxt, w4, KC + (size_t)cs_ * 4096, VC + (size_t)cs_ * 4096, koff, voff); }  \
        }
#define NA_READ(slot)                                                                                                                                  \
        LAS const bf16x8* im = (LAS const bf16x8*)(cur + (slot) * 16384) + lane;                                                                    \
        bf16x8 kf[4][2], vf[4][2];                                                                                                                    \
        _Pragma("unroll") for (int t = 0; t < 4; ++t) _Pragma("unroll") for (int kh = 0; kh < 2; ++kh) kf[t][kh] = im[(t * 2 + kh) * 64];       \
        _Pragma("unroll") for (int dt = 0; dt < 4; ++dt) _Pragma("unroll") for (int s2 = 0; s2 < 2; ++s2) vf[dt][s2] = im[(8 + dt * 2 + s2) * 64];
#pragma unroll 1
    for (int n = 0; n < 8; ++n) {
        NA_FRONT(n)
        const int ka = umin + ((n - umin) & 7), kw = r0 + ((n - r0) & 7);
        const int myslot = (kw == ka) ? 0 : 1, ridx = kw - row + 7;
        NA_READ(myslot)
        na_step<true>(o, qlds, mrow, lsum, kf, vf, rpbS + ridx * 128 + lanebase, vmask);
    }
#pragma unroll 1
    for (int n = 8; n < 12; ++n) {
        NA_FRONT(n)
        NA_READ(0)
        na_step<false>(o, qlds, mrow, lsum, kf, vf, rpbS, 0ull);
    }
#undef NA_FRONT
#undef NA_READ
    int lane2 = lane; asm volatile("" : "+v"(lane2));
    const unsigned ooff = (unsigned)(((lane2 & 15) * 512 + 4 * (lane2 >> 4)) * 2);
    char* YNA = (char*)((bf16_t*)(ws + WS_YNA) + qtok * 512 + h * 64);
#pragma unroll
    for (int g = 0; g < 4; ++g) {
        float l = lsum[g]; l += __shfl_xor(l, 16); l += __shfl_xor(l, 32);
        const float inv = frcp(l);
#pragma unroll
        for (int dt = 0; dt < 4; ++dt) {
            u32x2 w; w.x = cvt_pk_bf16(o[g][dt][0] * inv, o[g][dt][1] * inv); w.y = cvt_pk_bf16(o[g][dt][2] * inv, o[g][dt][3] * inv);
            *(u32x2*)(YNA + ((16 * g) * 1024 + 32 * dt) + (size_t)ooff) = w;
        }
    }
}

__device__ __forceinline__ bf16x8 scale8(bf16x8 v, const float (&w)[8]) {
    const u32x4 u = __builtin_bit_cast(u32x4, v); u32x4 o;
    o.x = cvt_pk_bf16(bf_lo(u.x) * w[0], bf_hi(u.x) * w[1]); o.y = cvt_pk_bf16(bf_lo(u.y) * w[2], bf_hi(u.y) * w[3]);
    o.z = cvt_pk_bf16(bf_lo(u.z) * w[4], bf_hi(u.z) * w[5]); o.w = cvt_pk_bf16(bf_lo(u.w) * w[6], bf_hi(u.w) * w[7]);
    return __builtin_bit_cast(bf16x8, o);
}
__device__ __forceinline__ void state_unit(int it, int lane, unsigned char* ws, const float* dlog) {
    const int cc = it % NCH, bh = it / NCH, h = bh & 7;
    const int r = lane & 15, q = lane >> 4;
    const size_t tb0 = (cc < 2) ? (TL_LAT + ((size_t)(bh * 8 + 4 * cc)) * 2048) : (((size_t)(bh * 128 + 4 * (cc - 2))) * 2048);
    const bf16_t* VT = (const bf16_t*)(ws + WS_RVT) + tb0;
    const bf16_t* KT = (const bf16_t*)(ws + WS_KTF) + tb0;
    const float lgf = lg2_decay(dlog[h]), lgb = lg2_decay(dlog[8 + h]);
    const f32x4 zero = {0.f, 0.f, 0.f, 0.f};
    f32x4 af[4][4], ab[4][4];
#pragma unroll
    for (int a = 0; a < 4; ++a)
#pragma unroll
        for (int c = 0; c < 4; ++c) { af[a][c] = zero; ab[a][c] = zero; }
#pragma unroll
    for (int ks = 0; ks < 4; ++ks) {
        bf16x8 kq[4], vv[4];
#pragma unroll
        for (int a = 0; a < 4; ++a) { kq[a] = *(const bf16x8*)(KT + (ks * 2048 + (16 * a + r) * 32 + 8 * q)); vv[a] = *(const bf16x8*)(VT + (ks * 2048 + (16 * a + r) * 32 + 8 * q)); }
        float wf[8], wb[8];
#pragma unroll
        for (int e = 0; e < 8; ++e) { const int jl = 32 * ks + 8 * q + e; wf[e] = fexp2(lgf * (float)(127 - jl)); wb[e] = fexp2(lgb * (float)jl); }
#pragma unroll
        for (int c = 0; c < 4; ++c) {
            const bf16x8 vf = scale8(vv[c], wf), vb = scale8(vv[c], wb);
#pragma unroll
            for (int a = 0; a < 4; ++a) { af[a][c] = mfma16(kq[a], vf, af[a][c]); ab[a][c] = mfma16(kq[a], vb, ab[a][c]); }
        }
    }
    float* S = (float*)(ws + WS_SB) + ((size_t)(bh * NCH + cc) * 2) * 4096;
#pragma unroll
    for (int c = 0; c < 4; ++c)
#pragma unroll
        for (int a = 0; a < 4; ++a) { *(f32x4*)(S + (16 * c + r) * 64 + 16 * a + 4 * q) = af[a][c]; *(f32x4*)(S + 4096 + (16 * c + r) * 64 + 16 * a + 4 * q) = ab[a][c]; }
}

__device__ __forceinline__ unsigned long long scan_pack(f32x4 a) { return (unsigned long long)cvt_pk_bf16(a[0], a[1]) | ((unsigned long long)cvt_pk_bf16(a[2], a[3]) << 32); }
__device__ __forceinline__ void scan_item(int it, unsigned char* ws, const float* dlog) {
    const int wit = __builtin_amdgcn_readfirstlane(it >> 6), ln = it & 63;
    const int bh = wit >> 5, dir = (wit >> 4) & 1, dv = ((wit & 15) << 2) | (ln >> 4), i2 = ln & 15, h = bh & 7;
    const float G = fexp2(lg2_decay(dlog[dir * 8 + h]) * 128.f);
    const char* S = (const char*)((const float*)(ws + WS_SB) + ((size_t)(bh * NCH) * 2 + dir) * 4096);
    char* R = (char*)((bf16_t*)(ws + WS_RB) + ((size_t)(bh * 32) * 2 + dir) * 4096);
    const unsigned soff = (unsigned)((dv * 64 + 4 * i2) * 4), roff = (unsigned)((dv * 64 + 4 * i2) * 2);
    f32x4 a[NCH - 1];
    if (dir == 0) {
#pragma unroll
        for (int k = 0; k < NCH - 1; ++k) a[k] = *(const f32x4*)(S + (size_t)k * 32768 + (size_t)soff);
    } else {
#pragma unroll
        for (int k = 0; k < NCH - 1; ++k) { const int cc = (k == 0 ? 1 : (k == 1 ? 0 : 35 - k)); a[k] = *(const f32x4*)(S + (size_t)cc * 32768 + (size_t)soff); }
    }
    f32x4 s0 = a[0];
    s0 = G * s0 + a[1];
    if (dir == 0) {
        *(unsigned long long*)(R + (size_t)roff) = scan_pack(s0);
#pragma unroll
        for (int k = 2; k < NCH - 1; ++k) { s0 = G * s0 + a[k]; *(unsigned long long*)(R + (size_t)(k - 1) * 16384 + (size_t)roff) = scan_pack(s0); }
    } else {
        *(unsigned long long*)(R + (size_t)31 * 16384 + (size_t)roff) = scan_pack(s0);
#pragma unroll
        for (int k = 2; k < NCH - 1; ++k) { s0 = G * s0 + a[k]; *(unsigned long long*)(R + (size_t)(32 - k) * 16384 + (size_t)roff) = scan_pack(s0); }
    }
}

__device__ __forceinline__ void ret_unit(int u, int wv, int lane, unsigned char* ws, const float* dlog, LAS unsigned char* img) {
    const int c = u & 31, bh = u >> 5, b = bh >> 3, h = bh & 7;
    const int r = lane & 15, q = lane >> 4;
    const size_t tok0 = (size_t)b * 4096 + 128 * c;
    const int i0 = 32 * wv + r;
    const size_t hm0 = ((size_t)(bh * 4096 + 128 * c)) * 64;
    const char* qb = (const char*)((const bf16_t*)(ws + WS_RQ) + hm0 + (32 * wv) * 64);
    const char* kb = (const char*)((const bf16_t*)(ws + WS_RK) + hm0);
    const char* vb = (const char*)((const bf16_t*)(ws + WS_RVT) + ((size_t)(bh * 128 + 4 * c)) * 2048);
    const char* rb = (const char*)((const bf16_t*)(ws + WS_RB) + ((size_t)(bh * 32 + c) * 2) * 4096);
    const char* gb = (const char*)((const bf16_t*)(ws + WS_RG) + hm0 + (32 * wv) * 64);
    const unsigned qoff = (unsigned)((r * 64 + 8 * q) * 2), koff = (unsigned)(((8 * (r >> 2) + (r & 3)) * 64 + 8 * q) * 2);
    const unsigned voff = (unsigned)((r * 32 + 8 * q) * 2), roff = (unsigned)((r * 64 + 8 * q) * 2), goff = (unsigned)((r * 64 + 4 * q) * 2), yoff = (unsigned)((r * 512 + 4 * q) * 2);
#pragma unroll
    for (int i = 0; i < 4; ++i) {
        const int t = 2 * wv + (i >> 1), kh = i & 1;
        __builtin_amdgcn_global_load_lds((const unsigned*)(kb + ((32 * (t >> 1) + 4 * (t & 1)) * 128 + kh * 64) + (size_t)koff), (LAS unsigned*)(img + (t * 2 + kh) * 1024), 16, 0, 0);
        __builtin_amdgcn_global_load_lds((const unsigned*)(vb + (1024 * wv + 4096 * i) + (size_t)voff), (LAS unsigned*)(img + 16384 + (wv * 4 + i) * 1024), 16, 0, 0);
        const int dir = wv >> 1, dt = 2 * (wv & 1) + (i >> 1);
        __builtin_amdgcn_global_load_lds((const unsigned*)(rb + (dir * 8192 + (16 * dt) * 128 + kh * 64) + (size_t)roff), (LAS unsigned*)(img + 32768 + ((dir * 4 + dt) * 2 + kh) * 1024), 16, 0, 0);
    }
    bf16x8 qf[2][2];
#pragma unroll
    for (int nt = 0; nt < 2; ++nt)
#pragma unroll
        for (int kh = 0; kh < 2; ++kh) qf[nt][kh] = *(const bf16x8*)(qb + (nt * 2048 + kh * 64) + (size_t)qoff);
    u32x2 gv[2][4];
#pragma unroll
    for (int nt = 0; nt < 2; ++nt)
#pragma unroll
        for (int dt = 0; dt < 4; ++dt) gv[nt][dt] = *(const u32x2*)(gb + (nt * 2048 + 32 * dt) + (size_t)goff);
    const float lgf = lg2_decay(dlog[h]), lgb = lg2_decay(dlog[8 + h]);
    asm volatile("s_waitcnt vmcnt(0)" ::: "memory");
    __syncthreads();
    LAS const bf16x8* im = (LAS const bf16x8*)img + lane;
    const f32x4 zero = {0.f, 0.f, 0.f, 0.f};
    bf16x8 pf[2][4];
#pragma unroll
    for (int s = 0; s < 4; ++s) {
        bf16x8 kf[2][2];
#pragma unroll
        for (int tb = 0; tb < 2; ++tb)
#pragma unroll
            for (int kh = 0; kh < 2; ++kh) kf[tb][kh] = im[((2 * s + tb) * 2 + kh) * 64];
#pragma unroll
        for (int nt = 0; nt < 2; ++nt) {
            unsigned pw[4];
#pragma unroll
            for (int tb = 0; tb < 2; ++tb) {
                f32x4 sc = mfma16(kf[tb][0], qf[nt][0], zero); sc = mfma16(kf[tb][1], qf[nt][1], sc);
                float p[4];
#pragma unroll
                for (int j = 0; j < 4; ++j) { const int d = (i0 + 16 * nt) - (32 * s + 8 * q + 4 * tb + j); const float w = (d >= 0) ? fexp2(lgf * (float)d) : fexp2(lgb * (float)(-d)); p[j] = sc[j] * w; }
                pw[2 * tb] = cvt_pk_bf16(p[0], p[1]); pw[2 * tb + 1] = cvt_pk_bf16(p[2], p[3]);
            }
            u32x4 w; w.x = pw[0]; w.y = pw[1]; w.z = pw[2]; w.w = pw[3];
            pf[nt][s] = __builtin_bit_cast(bf16x8, w);
        }
    }
    char* yb = (char*)((bf16_t*)(ws + WS_YRET) + (tok0 + 32 * wv) * 512 + h * 64);
    f32x4 o[2][4];
#pragma unroll
    for (int dt = 0; dt < 4; ++dt) {
        bf16x8 vf[4], rf[2], rk[2];
#pragma unroll
        for (int s = 0; s < 4; ++s) vf[s] = im[(16 + dt * 4 + s) * 64];
#pragma unroll
        for (int kh = 0; kh < 2; ++kh) { rf[kh] = im[(32 + dt * 2 + kh) * 64]; rk[kh] = im[(32 + (4 + dt) * 2 + kh) * 64]; }
#pragma unroll
        for (int nt = 0; nt < 2; ++nt) {
            const int i = i0 + 16 * nt;
            const float wf = fexp2(lgf * (float)(i + 1)), wb = fexp2(lgb * (float)(128 - i));
            f32x4 a = zero;
#pragma unroll
            for (int s = 0; s < 4; ++s) a = mfma16(vf[s], pf[nt][s], a);
            f32x4 cf = mfma16(rf[0], qf[nt][0], zero); cf = mfma16(rf[1], qf[nt][1], cf);
            f32x4 cb = mfma16(rk[0], qf[nt][0], zero); cb = mfma16(rk[1], qf[nt][1], cb);
#pragma unroll
            for (int j = 0; j < 4; ++j) a[j] += wf * cf[j] + wb * cb[j];
            o[nt][dt] = a;
        }
    }
#pragma unroll
    for (int nt = 0; nt < 2; ++nt) {
        float ss = 0.f;
#pragma unroll
        for (int dt = 0; dt < 4; ++dt)
#pragma unroll
            for (int j = 0; j < 4; ++j) ss += o[nt][dt][j] * o[nt][dt][j];
        ss += __shfl_xor(ss, 16); ss += __shfl_xor(ss, 32);
        const float rinv = rsqrtf(ss * (1.f / 64.f) + EPSN);
#pragma unroll
        for (int dt = 0; dt < 4; ++dt) {
            const u32x2 g = gv[nt][dt];
            const float g0 = bf_lo(g.x), g1 = bf_hi(g.x), g2 = bf_lo(g.y), g3 = bf_hi(g.y);
            const float y0 = o[nt][dt][0] * rinv * g0 * frcp(1.f + fexp2(-g0 * LOG2E)), y1 = o[nt][dt][1] * rinv * g1 * frcp(1.f + fexp2(-g1 * LOG2E));
            const float y2 = o[nt][dt][2] * rinv * g2 * frcp(1.f + fexp2(-g2 * LOG2E)), y3 = o[nt][dt][3] * rinv * g3 * frcp(1.f + fexp2(-g3 * LOG2E));
            u32x2 w; w.x = cvt_pk_bf16(y0, y1); w.y = cvt_pk_bf16(y2, y3);
            *(u32x2*)(yb + (nt * 16384 + 32 * dt) + (size_t)yoff) = w;
        }
    }
    __syncthreads();
}

#define XB_TMO      128
#define XB_XCNT(j)  (256  + 64 * (j))
#define XB_XSUB(j)  (1280 + 64 * (j))
#define XB_XGEN(j)  (2304 + 64 * (j))
#define XB_TOP      3328
#define XB_TOPGEN   3392
#define XCD_BAR_WORDS 3456
#define XB_SPIN_CAP (1u << 18)

__device__ __forceinline__ unsigned xb_ld(unsigned* p)              { return __hip_atomic_load(p, __ATOMIC_RELAXED, __HIP_MEMORY_SCOPE_AGENT); }
__device__ __forceinline__ unsigned xb_add(unsigned* p, unsigned v) { return __hip_atomic_fetch_add(p, v, __ATOMIC_RELAXED, __HIP_MEMORY_SCOPE_AGENT); }
__device__ __forceinline__ unsigned xb_xcc_id() { return (unsigned)__builtin_amdgcn_s_getreg((3 << 11) | 20) & 0xFu; }
#define XB_SPIN(cond, bar) do { unsigned _sp = 0; while (cond) { __builtin_amdgcn_s_sleep(1); \
    if ((++_sp & 255u) == 0u) { if (xb_ld(&(bar)[XB_TMO])) break; if (_sp > XB_SPIN_CAP) { atomicAdd(&(bar)[XB_TMO], 1u); break; } } } } while (0)

struct XcdBarrier {
    unsigned* bar; unsigned x;
    volatile LAS unsigned* st;
};

__device__ __forceinline__ XcdBarrier xcd_barrier_post(unsigned* bar, volatile LAS unsigned* st) {
    XcdBarrier b; b.bar = bar; b.x = xb_xcc_id(); b.st = st;
    if (threadIdx.x == 0) (void)xb_add(&bar[XB_XCNT(b.x)], 1u);
    return b;
}
__device__ __forceinline__ void xcd_barrier_complete(unsigned* bar, unsigned x, unsigned& nloc, unsigned& nx) {
    const unsigned G = gridDim.x * gridDim.y * gridDim.z;
    unsigned sum, cnt, mine, sp = 0u;
    for (;;) {
        sum = 0u; cnt = 0u; mine = 0u;
#pragma unroll
        for (unsigned j = 0; j < 16; ++j) { const unsigned c = xb_ld(&bar[XB_XCNT(j)]); sum += c; cnt += (c > 0u) ? 1u : 0u; mine = (j == x) ? c : mine; }
        if (sum == G) break;
        __builtin_amdgcn_s_sleep(1);
        if ((++sp & 255u) == 0u) { if (xb_ld(&bar[XB_TMO])) break; if (sp > XB_SPIN_CAP) { atomicAdd(&bar[XB_TMO], 1u); break; } }
    }
    nloc = mine > 0u ? mine : 1u; nx = cnt > 0u ? cnt : 1u;
}

__device__ __forceinline__ void xcd_barrier(const XcdBarrier& b) {
    asm volatile("s_waitcnt vmcnt(0)" ::: "memory");
    __syncthreads();
    if (threadIdx.x == 0) {
        unsigned* bar = b.bar;
        __builtin_amdgcn_s_waitcnt(0);
        unsigned nloc = b.st[0], nx = b.st[1];
        if (nloc == 0u) { xcd_barrier_complete(bar, b.x, nloc, nx); b.st[0] = nloc; b.st[1] = nx; }
        const unsigned old = xb_add(&bar[XB_XSUB(b.x)], 1u);
        const unsigned gen = old / nloc;
        if (old + 1u == (gen + 1u) * nloc) {
            __builtin_amdgcn_fence(__ATOMIC_RELEASE, "agent");
            asm volatile("s_waitcnt vmcnt(0)" ::: "memory");
            const unsigned og = xb_add(&bar[XB_TOP], 1u);
            const unsigned tg = og / nx;
            if (og + 1u == (tg + 1u) * nx) xb_add(&bar[XB_TOPGEN], 1u);
            else XB_SPIN(xb_ld(&bar[XB_TOPGEN]) == tg, bar);
            __builtin_amdgcn_fence(__ATOMIC_ACQUIRE, "agent");
            xb_add(&bar[XB_XGEN(b.x)], 1u);
            asm volatile("s_waitcnt vmcnt(0)" ::: "memory");
        } else {
            XB_SPIN(xb_ld(&bar[XB_XGEN(b.x)]) == gen, bar);
            __builtin_amdgcn_fence(__ATOMIC_ACQUIRE, "agent");
            asm volatile("s_waitcnt vmcnt(0)" ::: "memory");
        }
    }
    __syncthreads();
}

__device__ __forceinline__ int lane_of(int tid) { int t = tid; asm volatile("" : "+v"(t)); return t & 63; }
struct Args { const float* in[18]; float* outp; unsigned char* wsp; int ph_lo, ph_hi; };
constexpr int NPH = 13;

__global__ void __launch_bounds__(512, 2) mk_fwd(Args a) {
    extern __shared__ __attribute__((aligned(16))) unsigned char lds_raw[];
    LAS unsigned char* lds = (LAS unsigned char*)lds_raw;
    cg::grid_group grid = cg::this_grid();
    const int tid = threadIdx.x, wave = __builtin_amdgcn_readfirstlane(tid >> 6);
#define lane (lane_of(tid))
    const int G = gridDim.x, bx = blockIdx.x;
    if (tid < 64) ((LAS unsigned*)(lds + 131072))[tid] = 0u;
    __syncthreads();
    XcdBarrier xbar = xcd_barrier_post((unsigned*)(a.wsp + WS_BAR), (volatile LAS unsigned*)(lds + 131072));
    const int gw = bx * 8 + wave, NGW = G * 8;
#define ws (a.wsp)
#define XIN (a.in[0])
#define cvec (a.in[1])
#define ctx (a.in[2])
#define cctx (a.in[3])
#define w_ada (a.in[4])
#define b_ada (a.in[5])
#define g_pre_mix (a.in[6])
#define g_post_mix (a.in[7])
#define g_pre_ffn (a.in[8])
#define g_post_ffn (a.in[9])
#define dlog (a.in[11])
#define rpb (a.in[13])
#define MOD ((float*)(a.wsp + WS_MOD))
#define cosT ((float*)(a.wsp + WS_COS))
#define sinT ((float*)(a.wsp + WS_SIN))
#define out (a.outp)
    const int lo = a.ph_lo, hi = a.ph_hi;
#ifndef REP_MASK
#define REP_MASK 0
#endif
#ifndef SYNC_REP
#define SYNC_REP 1
#endif
#define TILE_RC(row, j, ln) ((((size_t)(((row) >> 8) * 4 + (j))) << 16) + (size_t)((((row) & 255) * 256) + 4 * (ln)))
#define IN(k) (lo <= (k) && (k) < hi)
#ifndef REP_CNT
#define REP_CNT 2
#endif
#define REPS(k) (((REP_MASK >> (k)) & 1) ? REP_CNT : 1)
#define SEAM(k) do { if (IN(k) && IN((k) + 1)) { for (int _s = 0; _s < SYNC_REP; ++_s) { if (lo < 0) grid.sync();     xcd_barrier(xbar); } } } while (0)

    if (IN(0)) for (int _rep = 0; _rep < REPS(0); ++_rep) { if (_rep) xcd_barrier(xbar);
        for (int it = bx; it < 192; it += G) ada_item(it, cvec, cctx, w_ada, b_ada, MOD, (LAS float*)lds, tid);
        if (bx == G - 1) {
            for (int idx = tid; idx < 1024; idx += 512) { const int pos = idx >> 4, f = idx & 15; const float inv = exp2f(-(float)f * (13.287712379549449f / 16.f)); const float ang = (float)pos * inv; cosT[idx] = __cosf(ang); sinT[idx] = __sinf(ang); }
        }
        __syncthreads();
        LAS float* scr = (LAS float*)(lds + wave * 8704);
        constexpr int I0 = 16 * 176, I1 = 8 * 32, I2 = 8 * 32, I3 = 16 * 32, I4 = 16 * 128, I5 = 64 * 32;
        const int nconv = (G == 256) ? I0 : (I0 + I1 + I2 + I3 + I4 + I5);
        for (int it = gw; it < nconv; it += NGW) {
            int rr = it;
            if (rr < I0) { conv_item(a.in[10], 1024, INC, 0, ws, scr, rr, lane); continue; } rr -= I0;
            if (rr < I1) { conv_item(a.in[12], 512, 1024, 1, ws, scr, rr, lane); continue; } rr -= I1;
            if (rr < I2) { conv_item(a.in[14], 512, 1024, 2, ws, scr, rr, lane); continue; } rr -= I2;
            if (rr < I3) { conv_item(a.in[15], 1024, 1024, 3, ws, scr, rr, lane); continue; } rr -= I3;
            if (rr < I4) { conv_item(a.in[16], 1024, 4096, 4, ws, scr, rr, lane); continue; } rr -= I4;
            conv_item(a.in[17], 4096, 1024, 5, ws, scr, rr, lane);
        }
    }
    SEAM(0);
    if (IN(1)) for (int _rep = 0; _rep < REPS(1); ++_rep) { if (_rep) xcd_barrier(xbar);
        bf16_t* XN = (bf16_t*)(ws + WS_XN);
        const int ln = lane;
        f32x4 nx[4];
        { const int row = gw; const float* src = (row < ML) ? (XIN + (size_t)row * 1024) : (ctx + (size_t)(row - ML) * 1024);
#pragma unroll
          for (int j = 0; j < 4; ++j) nx[j] = *(const f32x4*)(src + 4 * ln + 256 * j); }
        for (int row = gw; row < MT; row += NGW) {
            f32x4 v[4];
#pragma unroll
            for (int j = 0; j < 4; ++j) v[j] = nx[j];
            const int nrow = row + NGW;
            if (nrow < MT) { const float* src = (nrow < ML) ? (XIN + (size_t)nrow * 1024) : (ctx + (size_t)(nrow - ML) * 1024);
#pragma unroll
                for (int j = 0; j < 4; ++j) nx[j] = *(const f32x4*)(src + 4 * ln + 256 * j); }
            const float* mod = (row < ML) ? (MOD + (row >> 12) * 6144) : (MOD + 8 * 6144);
            float ss = 0.f;
#pragma unroll
            for (int j = 0; j < 4; ++j) ss += (v[j][0] * v[j][0] + v[j][1] * v[j][1]) + (v[j][2] * v[j][2] + v[j][3] * v[j][3]);
            const float rinv = rsqrtf(wave_sum(ss) * (1.f / 1024.f) + EPSN);
#pragma unroll
            for (int j = 0; j < 4; ++j) {
                const int c = 4 * ln + 256 * j;
                const f32x4 gg = *(const f32x4*)(g_pre_mix + c), s1 = *(const f32x4*)(mod + 1024 + c), s0 = *(const f32x4*)(mod + c);
                f32x4 hh;
#pragma unroll
                for (int e = 0; e < 4; ++e) hh[e] = v[j][e] * rinv * gg[e] * (1.f + s1[e]) + s0[e];
                u32x2 w; w.x = cvt_pk_bf16(hh[0], hh[1]); w.y = cvt_pk_bf16(hh[2], hh[3]);
                *(u32x2*)(XN + (size_t)row * 1024 + c) = w;
            }
        }
    }
    SEAM(1);
    if (IN(2)) for (int _rep = 0; _rep < REPS(2); ++_rep) { if (_rep) xcd_barrier(xbar);
        SchedInproj S{(const char*)(ws + WS_XN), (const char*)(ws + WS_WIN1), (const char*)(ws + WS_WIN2), G, bx};
        LAS float* ltab = (LAS float*)(lds + 132096);
        for (int idx = tid; idx < 1024; idx += 512) { ltab[idx] = cosT[idx]; ltab[1024 + idx] = sinT[idx]; }
        __syncthreads();
        EpiInproj E{ws, (bf16_t*)out, ltab, ltab + 1024, dlog};
        pg8::gemm_phase<EpiInproj, SchedInproj, true, true>(lds, 1024, S, E);
        if (G == 256 && bx >= 64) {
            LAS float* scr = (LAS float*)(lds + wave * 8704);
            constexpr int I1 = 8 * 32, I2 = 8 * 32, I3 = 16 * 32, I4 = 16 * 128, I5 = 64 * 32;
            for (int it = (bx - 64) * 8 + wave; it < I1 + I2 + I3 + I4 + I5; it += 192 * 8) {
                int rr = it;
                if (rr < I1) { conv_item(a.in[12], 512, 1024, 1, ws, scr, rr, lane); continue; } rr -= I1;
                if (rr < I2) { conv_item(a.in[14], 512, 1024, 2, ws, scr, rr, lane); continue; } rr -= I2;
                if (rr < I3) { conv_item(a.in[15], 1024, 1024, 3, ws, scr, rr, lane); continue; } rr -= I3;
                if (rr < I4) { conv_item(a.in[16], 1024, 4096, 4, ws, scr, rr, lane); continue; } rr -= I4;
                conv_item(a.in[17], 4096, 1024, 5, ws, scr, rr, lane);
            }
        }
    }
    SEAM(2);
    if (IN(3)) for (int _rep = 0; _rep < REPS(3); ++_rep) { if (_rep) xcd_barrier(xbar);
        for (int it = gw; it < 64 * NCH; it += NGW) state_unit(it, lane, ws, dlog);
        LAS float* rpbS = (LAS float*)(lds + 132096);
        const int vcu = (G % 8 == 0) ? ((bx % 8) * (G / 8) + bx / 8) : bx;
        for (int u = vcu; u < 512; u += G) {
            const int b = u >> 6, h = (u >> 3) & 7, rg = u & 7;
            __syncthreads();
            int t2 = tid; asm volatile("" : "+v"(t2));
            for (int idx = t2; idx < 15 * 128; idx += 512) { const int ri = idx >> 7, ci = (idx & 127) - 48; const float bv = (ci >= 0 && ci < 31) ? rpb[(h * 15 + ri) * 31 + ci] * LOG2E : 0.f;
                rpbS[idx] = bv; rpbS[15 * 128 + idx] = (ci >= 7 && ci <= 22) ? bv : -1e30f; }
            __syncthreads();
            na_unit(b, h, rg, wave, lane, ws, rpbS, lds);
        }
    }
    SEAM(3);
    if (IN(4)) for (int _rep = 0; _rep < REPS(4); ++_rep) { if (_rep) xcd_barrier(xbar);
        for (int it = bx * 512 + tid; it < 64 * 2 * 1024; it += G * 512) scan_item(it, ws, dlog);
    }
    SEAM(4);
    if (IN(5)) for (int _rep = 0; _rep < REPS(5); ++_rep) { if (_rep) xcd_barrier(xbar);
        LAS unsigned char* img = lds + (wave >> 2) * 49152;
        if (G == 256) { for (int k = 0; k < 4; ++k) ret_unit(bx * 8 + 2 * k + (wave >> 2), wave & 3, lane, ws, dlog, img); }
        else { for (int up = bx; up < 1024; up += G) ret_unit(2 * up + (wave >> 2), wave & 3, lane, ws, dlog, img); }
    }
    SEAM(5);
    if (IN(6)) for (int _rep = 0; _rep < REPS(6); ++_rep) { if (_rep) xcd_barrier(xbar);
        SchedSimple S{(const char*)(ws + WS_YRET), (const char*)(ws + WS_WR), 128, 4, G, bx, 0};
        EpiMerge<0> E{(const bf16_t*)out, (bf16_t*)(ws + WS_Z)};
        pg8::gemm_phase<EpiMerge<0>, SchedSimple, true, true>(lds, 512, S, E);
    }
    SEAM(6);
    if (IN(7)) for (int _rep = 0; _rep < REPS(7); ++_rep) { if (_rep) xcd_barrier(xbar);
        SchedSimple S{(const char*)(ws + WS_YNA), (const char*)(ws + WS_WN), 128, 4, G, bx, 0};
        EpiMerge<1> E{(const bf16_t*)out, (bf16_t*)(ws + WS_Z)};
        pg8::gemm_phase<EpiMerge<1>, SchedSimple, true, true>(lds, 512, S, E);
    }
    SEAM(7);
    if (IN(8)) for (int _rep = 0; _rep < REPS(8); ++_rep) { if (_rep) xcd_barrier(xbar);
        SchedSimple S{(const char*)(ws + WS_Z), (const char*)(ws + WS_WO), 128, 4, G, bx, 0};
        EpiPlain<0, 1> E{(bf16_t*)(ws + WS_Y), 1024};
        pg8::gemm_phase<EpiPlain<0, 1>, SchedSimple, true, true, true>(lds, 1024, S, E);
    }
    SEAM(8);
    if (IN(9)) for (int _rep = 0; _rep < REPS(9); ++_rep) { if (_rep) xcd_barrier(xbar);
        const bf16_t* Y = (const bf16_t*)(ws + WS_Y); bf16_t* H2 = (bf16_t*)(ws + WS_H2);
        const int ln = lane;
        f32x4 nx[4]; u32x2 ny[4];
#pragma unroll
        for (int j = 0; j < 4; ++j) { const int c = 4 * ln + 256 * j; ny[j] = *(const u32x2*)(Y + TILE_RC(gw, j, ln)); nx[j] = *(const f32x4*)(XIN + (size_t)gw * 1024 + c); }
        for (int row = gw; row < ML; row += NGW) {
            const float* mod = MOD + (row >> 12) * 6144;
            f32x4 y[4], xv[4]; float ss = 0.f;
#pragma unroll
            for (int j = 0; j < 4; ++j) {
                const u32x2 w = ny[j];
                y[j][0] = bf_lo(w.x); y[j][1] = bf_hi(w.x); y[j][2] = bf_lo(w.y); y[j][3] = bf_hi(w.y);
                xv[j] = nx[j];
                ss += (y[j][0] * y[j][0] + y[j][1] * y[j][1]) + (y[j][2] * y[j][2] + y[j][3] * y[j][3]);
            }
            const int nrow = row + NGW;
            if (nrow < ML) {
#pragma unroll
                for (int j = 0; j < 4; ++j) { const int c = 4 * ln + 256 * j; ny[j] = *(const u32x2*)(Y + TILE_RC(nrow, j, ln)); nx[j] = *(const f32x4*)(XIN + (size_t)nrow * 1024 + c); }
            }
            const float r1 = rsqrtf(wave_sum(ss) * (1.f / 1024.f) + EPSN);
            float ss2 = 0.f;
#pragma unroll
            for (int j = 0; j < 4; ++j) {
                const int c = 4 * ln + 256 * j;
                const f32x4 gp = *(const f32x4*)(g_post_mix + c), gt = *(const f32x4*)(mod + 2048 + c);
#pragma unroll
                for (int e = 0; e < 4; ++e) { xv[j][e] = xv[j][e] + gt[e] * (y[j][e] * r1 * gp[e]); ss2 += xv[j][e] * xv[j][e]; }
            }
            const float r2 = rsqrtf(wave_sum(ss2) * (1.f / 1024.f) + EPSN);
#pragma unroll
            for (int j = 0; j < 4; ++j) {
                const int c = 4 * ln + 256 * j;
                const f32x4 gg = *(const f32x4*)(g_pre_ffn + c), s0 = *(const f32x4*)(mod + 3072 + c), s1 = *(const f32x4*)(mod + 4096 + c);
                f32x4 hh;
#pragma unroll
                for (int e = 0; e < 4; ++e) hh[e] = xv[j][e] * r2 * gg[e] * (1.f + s1[e]) + s0[e];
                u32x2 w; w.x = cvt_pk_bf16(hh[0], hh[1]); w.y = cvt_pk_bf16(hh[2], hh[3]);
                *(u32x2*)(H2 + ((((size_t)((row >> 8) * 16 + (c >> 6))) * 256 + (row & 255)) * 64 + (c & 63))) = w;
            }
        }
    }
    SEAM(9);
    if (IN(10)) for (int _rep = 0; _rep < REPS(10); ++_rep) { if (_rep) xcd_barrier(xbar);
        SchedSimple S{(const char*)(ws + WS_H2), (const char*)(ws + WS_W1), 128, 16, G, bx, 0};
        EpiPlain<1, 2> E{(bf16_t*)(ws + WS_U), 4096};
        pg8::gemm_phase<EpiPlain<1, 2>, SchedSimple, true, true, true>(lds, 1024, S, E);
    }
    SEAM(10);
    if (IN(11)) for (int _rep = 0; _rep < REPS(11); ++_rep) { if (_rep) xcd_barrier(xbar);
        SchedSimple S{(const char*)(ws + WS_U), (const char*)(ws + WS_W2), 128, 4, G, bx, 0};
        EpiPlain<0, 1> E{(bf16_t*)(ws + WS_H2), 1024};
        pg8::gemm_phase<EpiPlain<0, 1>, SchedSimple, true, true, true>(lds, 4096, S, E);
    }
    SEAM(11);
    if (IN(12)) for (int _rep = 0; _rep < REPS(12); ++_rep) { if (_rep) xcd_barrier(xbar);
        const bf16_t* F = (const bf16_t*)(ws + WS_H2); const bf16_t* Y = (const bf16_t*)(ws + WS_Y);
        const int ln = lane;
        f32x4 nx[4]; u32x2 ny[4], nf[4];
#pragma unroll
        for (int j = 0; j < 4; ++j) { const int c = 4 * ln + 256 * j; nf[j] = *(const u32x2*)(F + TILE_RC(gw, j, ln)); ny[j] = *(const u32x2*)(Y + TILE_RC(gw, j, ln)); nx[j] = *(const f32x4*)(XIN + (size_t)gw * 1024 + c); }
        for (int row = gw; row < ML; row += NGW) {
            const float* mod = MOD + (row >> 12) * 6144;
            f32x4 y[4], f[4], xv[4]; float ss = 0.f, sf = 0.f;
#pragma unroll
            for (int j = 0; j < 4; ++j) {
                const u32x2 w = ny[j], v = nf[j];
                y[j][0] = bf_lo(w.x); y[j][1] = bf_hi(w.x); y[j][2] = bf_lo(w.y); y[j][3] = bf_hi(w.y);
                f[j][0] = bf_lo(v.x); f[j][1] = bf_hi(v.x); f[j][2] = bf_lo(v.y); f[j][3] = bf_hi(v.y);
                xv[j] = nx[j];
                ss += (y[j][0] * y[j][0] + y[j][1] * y[j][1]) + (y[j][2] * y[j][2] + y[j][3] * y[j][3]);
                sf += (f[j][0] * f[j][0] + f[j][1] * f[j][1]) + (f[j][2] * f[j][2] + f[j][3] * f[j][3]);
            }
            const int nrow = row + NGW;
            if (nrow < ML) {
#pragma unroll
                for (int j = 0; j < 4; ++j) { const int c = 4 * ln + 256 * j; nf[j] = *(const u32x2*)(F + TILE_RC(nrow, j, ln)); ny[j] = *(const u32x2*)(Y + TILE_RC(nrow, j, ln)); nx[j] = *(const f32x4*)(XIN + (size_t)nrow * 1024 + c); }
            }
#pragma unroll
            for (int o2 = 1; o2 < 64; o2 <<= 1) { ss += __shfl_xor(ss, o2); sf += __shfl_xor(sf, o2); }
            const float r1 = rsqrtf(ss * (1.f / 1024.f) + EPSN), r2 = rsqrtf(sf * (1.f / 1024.f) + EPSN);
#pragma unroll
            for (int j = 0; j < 4; ++j) {
                const int c = 4 * ln + 256 * j;
                const f32x4 gp = *(const f32x4*)(g_post_mix + c), gt = *(const f32x4*)(mod + 2048 + c);
                const f32x4 gq = *(const f32x4*)(g_post_ffn + c), gu = *(const f32x4*)(mod + 5120 + c);
#pragma unroll
                for (int e = 0; e < 4; ++e) { const float x1 = xv[j][e] + gt[e] * (y[j][e] * r1 * gp[e]); xv[j][e] = x1 + gu[e] * (f[j][e] * r2 * gq[e]); }
                *(f32x4*)(out + (size_t)row * 1024 + c) = xv[j];
            }
        }
    }
#undef IN
#undef SEAM
#undef lane
#undef ws
#undef XIN
#undef cvec
#undef ctx
#undef cctx
#undef w_ada
#undef b_ada
#undef g_pre_mix
#undef g_post_mix
#undef g_pre_ffn
#undef g_post_ffn
#undef dlog
#undef rpb
#undef MOD
#undef cosT
#undef sinT
#undef out
}

#ifndef MK_MULTI
#define MK_MULTI 0
#endif
extern "C" void kernel_launch(void* const* d_in, const int* in_sizes, int n_in, void* d_out, int out_size, void* d_ws, size_t ws_size, hipStream_t stream) {
    static int grid = 0;
    if (grid == 0) {
        if (n_in != 18 || out_size != ML * DM || ws_size < WS_END) { fprintf(stderr, "kernel_launch: unexpected problem (n_in %d out %d ws %zu)\n", n_in, out_size, ws_size); grid = -1; return; }
        int dev = 0, cus = 0, per_cu = 0;
        if (hipGetDevice(&dev) != hipSuccess || hipDeviceGetAttribute(&cus, hipDeviceAttributeMultiprocessorCount, dev) != hipSuccess) { grid = -1; return; }
        if (hipFuncSetAttribute((const void*)mk_fwd, hipFuncAttributeMaxDynamicSharedMemorySize, LDS_BYTES) != hipSuccess) { fprintf(stderr, "kernel_launch: hipFuncSetAttribute failed\n"); grid = -1; return; }
        if (hipOccupancyMaxActiveBlocksPerMultiprocessor(&per_cu, (const void*)mk_fwd, 512, LDS_BYTES) != hipSuccess || per_cu < 1) { fprintf(stderr, "kernel_launch: occupancy query says %d\n", per_cu); (void)hipGetLastError(); grid = -1; return; }
        grid = cus;
    }
    if (grid < 0) return;
    if (hipMemsetAsync((char*)d_ws + WS_BAR, 0, 16384, stream) != hipSuccess) { fprintf(stderr, "kernel_launch: memset failed\n"); return; }
    Args a{};
    for (int i = 0; i < 18; ++i) a.in[i] = (const float*)d_in[i];
    a.outp = (float*)d_out; a.wsp = (unsigned char*)d_ws;
#if MK_MULTI
    for (int p = 0; p < NPH; ++p) { a.ph_lo = p; a.ph_hi = p + 1; hipLaunchKernelGGL(mk_fwd, dim3(grid), dim3(512), LDS_BYTES, stream, a); }
#else
    a.ph_lo = 0; a.ph_hi = NPH;
    void* args[] = {&a};
    hipError_t e = hipLaunchCooperativeKernel((const void*)mk_fwd, dim3(grid), dim3(512), args, LDS_BYTES, stream);
    if (e != hipSuccess) fprintf(stderr, "kernel_launch: cooperative launch failed: %s (grid %d)\n", hipGetErrorString(e), grid);
#endif
}
```

```cpp
#include <hip/hip_runtime.h>
#include <hip/hip_cooperative_groups.h>
#include <cstdio>
#include <cstdint>
namespace cg = cooperative_groups;

#define PG8_LAS __attribute__((address_space(3)))
#define LAS __attribute__((address_space(3)))
typedef unsigned short bf16_t;
typedef short bf16x8 __attribute__((ext_vector_type(8)));
typedef float f32x4 __attribute__((ext_vector_type(4)));
typedef unsigned u32x4 __attribute__((ext_vector_type(4)));
typedef unsigned u32x2 __attribute__((ext_vector_type(2)));

constexpr int NB = 8, SEQ = 4096, DM = 1024, CTXL = 256, NH = 8, DH = 64, DFF = 4096, INC = 5632;
constexpr int ML = NB * SEQ, MC = NB * CTXL, MT = ML + MC;
constexpr int NCH = 34;
constexpr float LOG2E = 1.4426950408889634f;
constexpr float QSCALE = 0.125f * LOG2E;
constexpr float EPSN = 1e-6f;

constexpr size_t MiB = 1u << 20;
constexpr size_t WS_MOD = 0;
constexpr size_t WS_COS = 256 * 1024, WS_SIN = WS_COS + 4096;
constexpr size_t WS_BAR = 512 * 1024;
constexpr size_t WS_WIN1 = 2 * MiB;
constexpr size_t WS_WIN2 = 11 * MiB;
constexpr size_t WS_WR = 14 * MiB, WS_WN = 15 * MiB;
constexpr size_t WS_WO = 16 * MiB;
constexpr size_t WS_W1 = 18 * MiB;
constexpr size_t WS_W2 = 26 * MiB;
constexpr size_t WS_XN = 34 * MiB;
constexpr size_t WS_SB = WS_XN, WS_H2 = WS_XN;
constexpr size_t WS_RQ = 102 * MiB, WS_RK = 134 * MiB, WS_RG = 166 * MiB, WS_NQ = 198 * MiB, WS_NK = 230 * MiB;
constexpr size_t WS_RB = WS_NK;
constexpr size_t WS_KTF = 264 * MiB, WS_KTB = 298 * MiB, WS_RVT = 332 * MiB, WS_NVT = 366 * MiB;
constexpr size_t WS_Z = WS_KTF;
constexpr size_t WS_Y = WS_RQ;
constexpr size_t WS_U = 166 * MiB;
constexpr size_t WS_F = WS_RQ;
constexpr size_t WS_YNA = 422 * MiB, WS_YRET = 454 * MiB;
constexpr size_t WS_END = 486 * MiB;
constexpr int LDS_BYTES = 147456;

__device__ __forceinline__ unsigned cvt_pk_bf16(float lo, float hi) { unsigned r; asm volatile("v_cvt_pk_bf16_f32 %0, %1, %2" : "=v"(r) : "v"(lo), "v"(hi)); return r; }
__device__ __forceinline__ float bf_lo(unsigned w) { return __builtin_bit_cast(float, w << 16); }
__device__ __forceinline__ float bf_hi(unsigned w) { return __builtin_bit_cast(float, w & 0xffff0000u); }
__device__ __forceinline__ float fexp2(float x) { return __builtin_amdgcn_exp2f(x); }
__device__ __forceinline__ float frcp(float x) { return __builtin_amdgcn_rcpf(x); }
__device__ __forceinline__ float wave_sum(float v) {
#pragma unroll
    for (int o = 1; o < 64; o <<= 1) v += __shfl_xor(v, o);
    return v;
}
__device__ __forceinline__ f32x4 mfma16(bf16x8 a, bf16x8 b, f32x4 c) { return __builtin_amdgcn_mfma_f32_16x16x32_bf16(a, b, c, 0, 0, 0); }
__device__ __forceinline__ float lg2_decay(float logit) {
    const float e = __expf(-logit);
    float l1p;
    if (e < 0.1f) l1p = e * (1.f - e * (0.5f - e * (0.33333334f - e * (0.25f - e * (0.2f - e * (0.16666667f - e * 0.14285715f))))));
    else l1p = __logf(1.f + e);
    return -l1p * LOG2E;
}

namespace pg8 {
constexpr int BM = 256, BK = 64, HALF = 128, HTB = HALF * BK * 2, STAGE_BYTES = 8 * HTB, NXCD = 8, WGM = 8;
__host__ __device__ __forceinline__ int lds_byte(int r, int c) { const int st = (r >> 4) * 2 + (c >> 5), rr = r & 15, cc = c & 31, ob = rr * 64 + cc * 2; return st * 1024 + (ob ^ (((ob >> 9) & 1) << 5)); }
__host__ __device__ __forceinline__ void stage_rc(int b, int& R, int& C) { const int st = b / 1024, sb = b % 1024, swz = sb ^ (((sb >> 9) & 1) << 5); R = (st >> 1) * 16 + swz / 64; C = (st & 1) * 32 + (swz % 64) / 2; }
__host__ __device__ __forceinline__ int perm32(int rho) { const int n = rho >> 4, i = rho & 15; return 8 * (i >> 2) + 4 * n + (i & 3); }
struct Unit { int pm, pn, kind; };
__device__ __forceinline__ void map_tile(int L, int nM, int nN, int& pm, int& pn) {
    const int nwg = nM * nN; int wgid = L;
    { const int q = nwg / NXCD, r = nwg % NXCD, xcd = wgid % NXCD, off = wgid / NXCD; wgid = (xcd < r ? xcd * (q + 1) : r * (q + 1) + (xcd - r) * q) + off; }
    const int nig = WGM * nN, gid = wgid / nig, fm = gid * WGM, gsz = (nM - fm) < WGM ? (nM - fm) : WGM;
    pm = fm + ((wgid % nig) % gsz); pn = (wgid % nig) / gsz;
}

template <class Epi, class Sched, bool ALIGN_EPI = false, bool SP2 = false, bool ABLK = false>
__device__ __forceinline__ void gemm_phase(PG8_LAS unsigned char* lds, const int K, const Sched& S, const Epi& E) {
    const int tid = threadIdx.x, wid = __builtin_amdgcn_readfirstlane(tid >> 6), lane = tid & 63, wr = wid >> 2, wc = wid & 3, fr = lane & 15, fq = lane >> 4;
    const int nt = K / BK;
    unsigned voffA[2], voffB[2];
#pragma unroll
    for (int i = 0; i < 2; ++i) { int R, C; stage_rc(tid * 16 + i * 8192, R, C); const int Rb = Epi::PERM ? ((R & ~31) + perm32(R & 31)) : R;
        voffA[i] = (unsigned)(R * (ABLK ? 64 : K) + C) * 2u; voffB[i] = (unsigned)(Rb * K + C) * 2u; }
    const size_t kstep = (size_t)(BK * 2);
    const size_t hstep = (size_t)HALF * K * 2;
    const size_t tstep = 2 * hstep;
    const size_t kstepA = ABLK ? (size_t)32768 : kstep, hstepA = ABLK ? (size_t)16384 : hstep;
    const unsigned ldsw = (unsigned)wid * 1024u;
    const int aoff = lds_byte(wr * 64 + fr, fq * 8), boff = lds_byte(wc * 32 + fr, fq * 8);
#define PG8_SA(b, h) (((b) * 2 + (h)) * HTB)
#define PG8_SB(b, h) ((4 + (b) * 2 + (h)) * HTB)
#define PG8_STAGE(bufoff, gbase, voff) do { _Pragma("unroll") for (int _i = 0; _i < 2; ++_i) \
        __builtin_amdgcn_global_load_lds((const unsigned*)((const char*)(gbase) + (voff)[_i]), (PG8_LAS unsigned*)(lds + (bufoff) + ldsw + _i * 8192), 16, 0, 0); } while (0)
#define PG8_LDA(dst, b, h) do { _Pragma("unroll") for (int m = 0; m < 4; ++m) _Pragma("unroll") for (int k = 0; k < 2; ++k) dst[m][k] = *(const PG8_LAS bf16x8*)(lds + PG8_SA(b, h) + aoff + m * 2048 + k * 1024); } while (0)
#define PG8_LDB(dst, b, h) do { _Pragma("unroll") for (int n = 0; n < 2; ++n) _Pragma("unroll") for (int k = 0; k < 2; ++k) dst[n][k] = *(const PG8_LAS bf16x8*)(lds + PG8_SB(b, h) + boff + n * 2048 + k * 1024); } while (0)
#define PG8_MMA(ai, bj, At, Bt) do { __builtin_amdgcn_s_setprio(1); _Pragma("unroll") for (int m = 0; m < 4; ++m) _Pragma("unroll") for (int n = 0; n < 2; ++n) _Pragma("unroll") for (int k = 0; k < 2; ++k) \
        acc[ai][bj][m][n] = __builtin_amdgcn_mfma_f32_16x16x32_bf16(Bt[n][k], At[m][k], acc[ai][bj][m][n], 0, 0, 0); __builtin_amdgcn_s_setprio(0); } while (0)
#define PG8_WAIT_V(n) asm volatile("s_waitcnt vmcnt(" #n ")" ::: "memory")
#define PG8_WAIT_L(n) asm volatile("s_waitcnt lgkmcnt(" #n ")" ::: "memory")
#define PG8_BAR __builtin_amdgcn_s_barrier()
#define PG8_SCHED __builtin_amdgcn_sched_barrier(0)
    Unit cur, nxt; int ui = 0;
    if (!S.next(0, cur)) return;
    f32x4 acc[2][2][4][2];
#pragma unroll
    for (int a = 0; a < 2; ++a)
#pragma unroll
        for (int b = 0; b < 2; ++b)
#pragma unroll
            for (int m = 0; m < 4; ++m)
#pragma unroll
                for (int n = 0; n < 2; ++n) acc[a][b][m][n] = (f32x4){0.f, 0.f, 0.f, 0.f};
    bf16x8 At[4][2], B0[2][2], B1[2][2];
    const char* cA; const char* cB; S.ptrs(cur, tstep, cA, cB);
    if constexpr (SP2) {
        PG8_STAGE(PG8_SB(0, 0), cB, voffB); PG8_STAGE(PG8_SB(0, 1), cB + hstep, voffB); PG8_STAGE(PG8_SA(0, 0), cA, voffA); PG8_STAGE(PG8_SA(0, 1), cA + hstepA, voffA);
        if (wr == 1) PG8_BAR;
        PG8_WAIT_V(2); PG8_BAR;
        PG8_STAGE(PG8_SB(1, 0), cB + kstep, voffB); PG8_STAGE(PG8_SA(1, 0), cA + kstepA, voffA); PG8_STAGE(PG8_SB(1, 1), cB + hstep + kstep, voffB);
        PG8_WAIT_V(6); PG8_BAR;
    } else {
        PG8_STAGE(PG8_SB(0, 0), cB, voffB); PG8_STAGE(PG8_SA(0, 0), cA, voffA); PG8_STAGE(PG8_SB(0, 1), cB + hstep, voffB); PG8_STAGE(PG8_SA(0, 1), cA + hstepA, voffA);
        if (wr == 1) PG8_BAR;
        PG8_WAIT_V(4); PG8_BAR;
        PG8_STAGE(PG8_SB(1, 0), cB + kstep, voffB); PG8_STAGE(PG8_SA(1, 0), cA + kstepA, voffA); PG8_STAGE(PG8_SB(1, 1), cB + hstep + kstep, voffB);
        PG8_WAIT_V(6); PG8_BAR;
    }
    for (;;) {
        const bool has_next = S.next(ui + 1, nxt);
        const char* nA = cA; const char* nB = cB; if (has_next) S.ptrs(nxt, tstep, nA, nB);
        for (int t = 0; t < nt; t += 2) {
            const bool last = (t == nt - 2);
            const char* a1 = cA + (size_t)(t + 1) * kstepA;
            const char* a2 = last ? nA : cA + (size_t)(t + 2) * kstepA; const char* b2 = last ? nB : cB + (size_t)(t + 2) * kstep;
            const char* a3 = a2 + kstepA; const char* b3 = b2 + kstep;
            if constexpr (SP2) {
            PG8_LDB(B0, 0, 0); PG8_LDB(B1, 0, 1); PG8_SCHED; PG8_LDA(At, 0, 0); PG8_STAGE(PG8_SA(1, 1), a1 + hstepA, voffA);
            PG8_WAIT_V(8); PG8_WAIT_L(0); PG8_BAR; PG8_MMA(0, 0, At, B0); PG8_MMA(0, 1, At, B1); PG8_BAR; PG8_SCHED;
            PG8_LDA(At, 0, 1); PG8_STAGE(PG8_SB(0, 0), b2, voffB); PG8_STAGE(PG8_SB(0, 1), b2 + hstep, voffB); PG8_STAGE(PG8_SA(0, 0), a2, voffA);
            PG8_WAIT_V(8); PG8_WAIT_L(0); PG8_BAR; PG8_MMA(1, 0, At, B0); PG8_MMA(1, 1, At, B1); PG8_BAR; PG8_SCHED;
            PG8_LDB(B0, 1, 0); PG8_LDB(B1, 1, 1); PG8_SCHED; PG8_LDA(At, 1, 0); PG8_STAGE(PG8_SA(0, 1), a2 + hstepA, voffA);
            PG8_WAIT_V(8); PG8_WAIT_L(0); PG8_BAR; PG8_MMA(0, 0, At, B0); PG8_MMA(0, 1, At, B1); PG8_BAR; PG8_SCHED;
            PG8_LDA(At, 1, 1); PG8_STAGE(PG8_SB(1, 0), b3, voffB); PG8_STAGE(PG8_SB(1, 1), b3 + hstep, voffB); PG8_STAGE(PG8_SA(1, 0), a3, voffA);
            PG8_WAIT_V(8); PG8_WAIT_L(0); PG8_BAR; PG8_MMA(1, 0, At, B0); PG8_MMA(1, 1, At, B1); PG8_BAR; PG8_SCHED;
            } else {
            PG8_LDB(B0, 0, 0); PG8_SCHED; PG8_LDA(At, 0, 0); PG8_STAGE(PG8_SA(1, 1), a1 + hstepA, voffA);
            PG8_WAIT_L(8); PG8_BAR; PG8_WAIT_L(0); PG8_MMA(0, 0, At, B0); PG8_BAR; PG8_SCHED;
            PG8_LDB(B1, 0, 1); PG8_STAGE(PG8_SB(0, 0), b2, voffB);
            PG8_BAR; PG8_WAIT_L(0); PG8_MMA(0, 1, At, B1); PG8_BAR;
            PG8_LDA(At, 0, 1); PG8_STAGE(PG8_SA(0, 0), a2, voffA);
            PG8_BAR; PG8_WAIT_L(0); PG8_MMA(1, 0, At, B0); PG8_BAR; PG8_SCHED;
            PG8_STAGE(PG8_SB(0, 1), b2 + hstep, voffB);
            PG8_WAIT_V(6); PG8_BAR; PG8_MMA(1, 1, At, B1); PG8_BAR;
            PG8_LDB(B0, 1, 0); PG8_SCHED; PG8_LDA(At, 1, 0); PG8_STAGE(PG8_SA(0, 1), a2 + hstepA, voffA);
            PG8_WAIT_L(8); PG8_BAR; PG8_WAIT_L(0); PG8_MMA(0, 0, At, B0); PG8_BAR; PG8_SCHED;
            PG8_LDB(B1, 1, 1); PG8_STAGE(PG8_SB(1, 0), b3, voffB);
            PG8_BAR; PG8_WAIT_L(0); PG8_MMA(0, 1, At, B1); PG8_BAR;
            PG8_LDA(At, 1, 1); PG8_STAGE(PG8_SA(1, 0), a3, voffA);
            PG8_BAR; PG8_WAIT_L(0); PG8_MMA(1, 0, At, B0); PG8_BAR; PG8_SCHED;
            PG8_STAGE(PG8_SB(1, 1), b3 + hstep, voffB);
            PG8_WAIT_V(6); PG8_BAR; PG8_MMA(1, 1, At, B1); PG8_BAR;
            }
        }
        if constexpr (ALIGN_EPI) { if (wr == 0) PG8_BAR; }
        E(acc, cur, wr, wc, fr, fq);
        if (!has_next) break;
#pragma unroll
        for (int a = 0; a < 2; ++a)
#pragma unroll
            for (int b = 0; b < 2; ++b)
#pragma unroll
                for (int m = 0; m < 4; ++m)
#pragma unroll
                    for (int n = 0; n < 2; ++n) acc[a][b][m][n] = (f32x4){0.f, 0.f, 0.f, 0.f};
        cur = nxt; cA = nA; cB = nB; ++ui;
        if constexpr (ALIGN_EPI) { if (wr == 1) PG8_BAR; }
    }
    PG8_WAIT_V(0);
    if constexpr (!ALIGN_EPI) { if (wr == 0) PG8_BAR; }
    PG8_BAR;
#undef PG8_SA
#undef PG8_SB
#undef PG8_STAGE
#undef PG8_LDA
#undef PG8_LDB
#undef PG8_MMA
#undef PG8_WAIT_V
#undef PG8_WAIT_L
#undef PG8_BAR
#undef PG8_SCHED
}
}

struct SchedSimple {
    const char* A; const char* B; int nM, nN, G, c, kind;
    __device__ __forceinline__ bool next(int i, pg8::Unit& u) const { const int L = i * G + c; if (L >= nM * nN) return false; pg8::map_tile(L, nM, nN, u.pm, u.pn); u.kind = kind; return true; }
    __device__ __forceinline__ void ptrs(const pg8::Unit& u, size_t tstep, const char*& a, const char*& b) const { a = A + (size_t)u.pm * tstep; b = B + (size_t)u.pn * tstep; }
};
struct SchedInproj {
    const char* XN; const char* W1; const char* W2; int G, c;
    static constexpr int N0 = 128 * 18, N1 = 4 * 136, N2 = 32;
    __device__ __forceinline__ bool next(int i, pg8::Unit& u) const {
        const int L = i * G + c;
        if (L < N0) { pg8::map_tile(L, 128, 18, u.pm, u.pn); u.kind = 0; return true; }
        if (L < N0 + N1) { pg8::map_tile(L - N0, 4, 136, u.pm, u.pn); u.kind = 1; return true; }
        if (L < N0 + N1 + N2) { const int l = L - N0 - N1; u.pm = 128 + (l & 7); u.pn = ((l >> 3) < 2) ? (2 + (l >> 3)) : (6 + (l >> 3)); u.kind = 0; return true; }
        return false;
    }
    __device__ __forceinline__ void ptrs(const pg8::Unit& u, size_t tstep, const char*& a, const char*& b) const {
        if (u.kind == 0) { a = XN + (size_t)u.pm * tstep; b = W1 + (size_t)u.pn * tstep; }
        else { a = W2 + (size_t)u.pm * tstep; b = XN + (size_t)u.pn * tstep; }
    }
};

typedef const f32x4 (&AccRef)[2][2][4][2];
__device__ __forceinline__ u32x4 pack8(f32x4 v0, f32x4 v1) { u32x4 w; w.x = cvt_pk_bf16(v0[0], v0[1]); w.y = cvt_pk_bf16(v0[2], v0[3]); w.z = cvt_pk_bf16(v1[0], v1[1]); w.w = cvt_pk_bf16(v1[2], v1[3]); return w; }

constexpr size_t TL_LAT = (size_t)64 * 128 * 2048;
__device__ __forceinline__ size_t tl_off(int tok, int hh, int d) {
    if (tok < ML) { const int b = tok >> 12, n = tok & 4095; return ((size_t)(((b * 8 + hh) * 128 + (n >> 5)) * 64 + d)) * 32 + (n & 31); }
    const int t = tok - ML, b = t >> 8, j = t & 255; return TL_LAT + ((size_t)(((b * 8 + hh) * 8 + (j >> 5)) * 64 + d)) * 32 + (j & 31);
}
struct EpiInproj {
    static constexpr bool PERM = true;
    unsigned char* ws; bf16_t* gates; LAS const float* cosT; LAS const float* sinT; const float* dlog;
    __device__ __forceinline__ void rowmajor(AccRef acc, const pg8::Unit& u, int wr, int wc, int fr, int fq) const {
        const int ct = u.pn; bf16_t* base; int ld, colt, typ;
        if (ct < 10) { typ = ct >> 1; base = (bf16_t*)(ws + WS_RQ + (size_t)typ * 32 * MiB); ld = 512; colt = (ct & 1) * 256; }
        else { typ = 5; base = gates; ld = 2048; colt = (ct - 10) * 256; }
        const int row0 = u.pm * 256 + wr * 64 + fr, col0 = colt + wc * 32 + 8 * fq;
#pragma unroll
        for (int ai = 0; ai < 2; ++ai)
#pragma unroll
            for (int m = 0; m < 4; ++m) {
                const int row = row0 + ai * 128 + m * 16; const int nl = row & 4095, rowpos = nl >> 6, colpos = nl & 63;
#pragma unroll
                for (int bj = 0; bj < 2; ++bj) {
                    const int col = col0 + bj * 128; f32x4 v0 = acc[ai][bj][m][0], v1 = acc[ai][bj][m][1];
                    if (typ == 1 && row >= ML) { v0 = v0 * 0.125f; v1 = v1 * 0.125f; }
                    else if (typ <= 1) {
                        const int i0 = (col & 63) >> 1, pos = (i0 < 16) ? rowpos : colpos, f0 = i0 & 15;
                        const f32x4 cs = *(LAS const f32x4*)(cosT + pos * 16 + f0), sn = *(LAS const f32x4*)(sinT + pos * 16 + f0);
                        const float sc = (typ == 1) ? 0.125f : 1.f;
                        f32x4 a, b;
                        a[0] = (v0[0] * cs[0] - v0[1] * sn[0]) * sc; a[1] = (v0[0] * sn[0] + v0[1] * cs[0]) * sc;
                        a[2] = (v0[2] * cs[1] - v0[3] * sn[1]) * sc; a[3] = (v0[2] * sn[1] + v0[3] * cs[1]) * sc;
                        b[0] = (v1[0] * cs[2] - v1[1] * sn[2]) * sc; b[1] = (v1[0] * sn[2] + v1[1] * cs[2]) * sc;
                        b[2] = (v1[2] * cs[3] - v1[3] * sn[3]) * sc; b[3] = (v1[2] * sn[3] + v1[3] * cs[3]) * sc;
                        v0 = a; v1 = b;
                    } else if (typ == 3) { v0 = v0 * QSCALE; v1 = v1 * QSCALE; }
                    else if (typ == 5) {
#pragma unroll
                        for (int e = 0; e < 4; ++e) { v0[e] = frcp(1.f + fexp2(-v0[e] * LOG2E)); v1[e] = frcp(1.f + fexp2(-v1[e] * LOG2E)); }
                    }
                    if (typ == 1) {
                        const int hh = col >> 6;
                        const bool odd = (fr & 1) != 0;
                        const size_t to = tl_off(row & ~1, hh, (col & 63) + (odd ? 4 : 0));
                        unsigned* tf = (unsigned*)((bf16_t*)(ws + WS_KTF) + to);
#pragma unroll
                        for (int e = 0; e < 4; ++e) {
                            const float mine = odd ? v1[e] : v0[e], send = odd ? v0[e] : v1[e];
                            const float rf = __builtin_bit_cast(float, __builtin_amdgcn_update_dpp(0, __builtin_bit_cast(int, send), 0xB1, 0xF, 0xF, false));
                            tf[e * 16] = odd ? cvt_pk_bf16(rf, mine) : cvt_pk_bf16(mine, rf);
                        }
                        if (row >= ML) continue;
                    }
                    size_t doff;
                    if (typ == 5) doff = ((size_t)((row >> 8) * 8 + (col >> 8)) << 16) + (size_t)((row & 255) * 256 + (col & 255));
                    else if (row < ML) doff = ((size_t)(((row >> 12) * 8 + (col >> 6)) * 4096 + (row & 4095))) * 64 + (col & 63);
                    else doff = (size_t)ML * 512 + ((size_t)((((row - ML) >> 8) * 8 + (col >> 6)) * 256 + ((row - ML) & 255))) * 64 + (col & 63);
                    *(u32x4*)(base + doff) = pack8(v0, v1);
                }
            }
    }
    __device__ __forceinline__ void transposed(AccRef acc, const pg8::Unit& u, int wr, int wc, int fr, int fq) const {
        const int region = u.pm >> 1;
        const int tok0 = u.pn * 256 + wc * 32 + 8 * fq;
        bf16_t* base = (bf16_t*)(ws + (region == 0 ? WS_RVT : WS_NVT));
        const int rowb = (u.pm & 1) * 256 + wr * 64 + fr;
#pragma unroll
        for (int ai = 0; ai < 2; ++ai)
#pragma unroll
            for (int m = 0; m < 4; ++m) {
                const int row = rowb + ai * 128 + m * 16;
#pragma unroll
                for (int bj = 0; bj < 2; ++bj) *(u32x4*)(base + tl_off(tok0 + bj * 128, row >> 6, row & 63)) = pack8(acc[ai][bj][m][0], acc[ai][bj][m][1]);
            }
    }
    __device__ __forceinline__ void operator()(AccRef acc, const pg8::Unit& u, int wr, int wc, int fr, int fq) const {
        if (u.kind == 0) rowmajor(acc, u, wr, wc, fr, fq); else transposed(acc, u, wr, wc, fr, fq);
    }
};

template <int TERM> struct EpiMerge {
    static constexpr bool PERM = true;
    const bf16_t* gates; bf16_t* Z;
    __device__ __forceinline__ void operator()(AccRef acc, const pg8::Unit& u, int wr, int wc, int fr, int fq) const {
        const int row0 = u.pm * 256 + wr * 64 + fr, col0 = u.pn * 256 + wc * 32 + 8 * fq;
#pragma unroll
        for (int ai = 0; ai < 2; ++ai)
#pragma unroll
            for (int m = 0; m < 4; ++m) {
                const int row = row0 + ai * 128 + m * 16;
#pragma unroll
                for (int bj = 0; bj < 2; ++bj) {
                    const int col = col0 + bj * 128;
                    const u32x4 g = *(const u32x4*)(gates + (((size_t)((row >> 8) * 8 + TERM * 4 + (col >> 8))) << 16) + (size_t)((row & 255) * 256 + (col & 255)));
                    f32x4 v0 = acc[ai][bj][m][0], v1 = acc[ai][bj][m][1];
                    v0[0] *= bf_lo(g.x); v0[1] *= bf_hi(g.x); v0[2] *= bf_lo(g.y); v0[3] *= bf_hi(g.y);
                    v1[0] *= bf_lo(g.z); v1[1] *= bf_hi(g.z); v1[2] *= bf_lo(g.w); v1[3] *= bf_hi(g.w);
                    bf16_t* zp = Z + ((((size_t)((row >> 8) * 16 + (col >> 6))) * 256 + (row & 255)) * 64 + (col & 63));
                    if (TERM == 1) {
                        const u32x4 z = *(const u32x4*)zp;
                        v0[0] += bf_lo(z.x); v0[1] += bf_hi(z.x); v0[2] += bf_lo(z.y); v0[3] += bf_hi(z.y);
                        v1[0] += bf_lo(z.z); v1[1] += bf_hi(z.z); v1[2] += bf_lo(z.w); v1[3] += bf_hi(z.w);
                    }
                    *(u32x4*)zp = pack8(v0, v1);
                }
            }
    }
};

template <int ACT, int TILED = 0> struct EpiPlain {
    static constexpr bool PERM = true;
    bf16_t* O; int ld;
    __device__ __forceinline__ void operator()(AccRef acc, const pg8::Unit& u, int wr, int wc, int fr, int fq) const {
        const int row0 = u.pm * 256 + wr * 64 + fr, col0 = u.pn * 256 + wc * 32 + 8 * fq;
#pragma unroll
        for (int ai = 0; ai < 2; ++ai)
#pragma unroll
            for (int m = 0; m < 4; ++m) {
                const int row = row0 + ai * 128 + m * 16;
#pragma unroll
                for (int bj = 0; bj < 2; ++bj) {
                    f32x4 v0 = acc[ai][bj][m][0], v1 = acc[ai][bj][m][1];
                    if (ACT == 1) {
#pragma unroll
                        for (int e = 0; e < 4; ++e) { const float a = fmaxf(v0[e], 0.f), b = fmaxf(v1[e], 0.f); v0[e] = a * a; v1[e] = b * b; }
                    }
                    const int col = col0 + bj * 128;
                    const size_t off = (TILED == 2) ? ((((size_t)((row >> 8) * (ld >> 6) + (col >> 6))) * 256 + (row & 255)) * 64 + (col & 63)) : (TILED == 1) ? ((((size_t)((row >> 8) * (ld >> 8) + (col >> 8))) << 16) + (size_t)((row & 255) * 256 + (col & 255))) : ((size_t)row * ld + col);
                    *(u32x4*)(O + off) = pack8(v0, v1);
                }
            }
    }
};

__device__ __forceinline__ void conv_item(const float* W, int K, int N, int mat, unsigned char* ws, LAS float* scr, int item, int lane) {
    const int nblk = N / 32, kb = item / nblk, nb = item % nblk, k0 = 64 * kb, n0 = 32 * nb;
#pragma unroll 8
    for (int i = 0; i < 32; ++i) { const int kk = 2 * i + (lane >> 5); scr[kk * 33 + (lane & 31)] = W[(size_t)(k0 + kk) * N + n0 + (lane & 31)]; }
    asm volatile("s_waitcnt vmcnt(0) lgkmcnt(0)" ::: "memory");
    const int c = lane & 7;
#pragma unroll
    for (int j = 0; j < 4; ++j) {
        const int n = (lane >> 3) + 8 * j; const LAS float* s = scr + (8 * c) * 33 + n;
        u32x4 o; o.x = cvt_pk_bf16(s[0 * 33], s[1 * 33]); o.y = cvt_pk_bf16(s[2 * 33], s[3 * 33]); o.z = cvt_pk_bf16(s[4 * 33], s[5 * 33]); o.w = cvt_pk_bf16(s[6 * 33], s[7 * 33]);
        const int gn = n0 + n;
        bf16_t* d0; bf16_t* d1 = nullptr;
        bf16_t* win1 = (bf16_t*)(ws + WS_WIN1); bf16_t* win2 = (bf16_t*)(ws + WS_WIN2);
        if (mat == 0) {
            if (gn < 1024) {
                const int which = gn >> 9, cc = gn & 511, hh = cc >> 6, d = cc & 63, p = (d < 32) ? 2 * d : 2 * (d - 32) + 1;
                d0 = win1 + (size_t)(which * 512 + hh * 64 + p) * 1024;
            } else if (gn < 1536) d0 = win2 + (size_t)(gn - 1024) * 1024;
            else if (gn < 2048) d0 = win1 + (size_t)(1024 + gn - 1536) * 1024;
            else if (gn < 2560) d0 = win1 + (size_t)(1536 + gn - 2048) * 1024;
            else if (gn < 3072) d0 = win1 + (size_t)(2048 + gn - 2560) * 1024;
            else if (gn < 3584) d0 = win2 + (size_t)(512 + gn - 3072) * 1024;
            else d0 = win1 + (size_t)(2560 + gn - 3584) * 1024;
        } else {
            const size_t off = (mat == 1) ? WS_WR : (mat == 2) ? WS_WN : (mat == 3) ? WS_WO : (mat == 4) ? WS_W1 : WS_W2;
            d0 = (bf16_t*)(ws + off) + (size_t)gn * K;
        }
        *(u32x4*)(d0 + k0 + 8 * c) = o;
        if (d1) *(u32x4*)(d1 + k0 + 8 * c) = o;
    }
    asm volatile("s_waitcnt lgkmcnt(0)" ::: "memory");
}

__device__ __forceinline__ void ada_item(int it, const float* cvec, const float* cctx, const float* w_ada, const float* b_ada, float* MOD, LAS float* lds, int tid) {
    LAS float* sl = lds;
    LAS float* red = lds + 9 * 1024;
    for (int idx = tid; idx < 9 * 1024; idx += 512) { const int bb = idx >> 10, k = idx & 1023; const float v = (bb < 8) ? cvec[bb * 1024 + k] : cctx[k]; sl[idx] = v * frcp(1.f + __expf(-v)); }
    __syncthreads();
    const int col = tid & 31, ks = tid >> 5, j0 = it * 32;
    float a0 = 0.f, a1 = 0.f, a2 = 0.f, a3 = 0.f, a4 = 0.f, a5 = 0.f, a6 = 0.f, a7 = 0.f, a8 = 0.f;
#pragma unroll 16
    for (int kk = 0; kk < 64; ++kk) {
        const int k = ks * 64 + kk; const float w = w_ada[(size_t)k * 6144 + j0 + col];
        a0 += sl[k] * w; a1 += sl[1024 + k] * w; a2 += sl[2048 + k] * w; a3 += sl[3072 + k] * w; a4 += sl[4096 + k] * w;
        a5 += sl[5120 + k] * w; a6 += sl[6144 + k] * w; a7 += sl[7168 + k] * w; a8 += sl[8192 + k] * w;
    }
    LAS float* rp = red + ks * 288 + col;
    rp[0] = a0; rp[32] = a1; rp[64] = a2; rp[96] = a3; rp[128] = a4; rp[160] = a5; rp[192] = a6; rp[224] = a7; rp[256] = a8;
    __syncthreads();
    if (tid < 288) { float s = 0.f;
#pragma unroll
        for (int q = 0; q < 16; ++q) s += red[q * 288 + tid];
        const int bb = tid >> 5, cc = tid & 31; MOD[bb * 6144 + j0 + cc] = s + b_ada[j0 + cc]; }
    __syncthreads();
}

__device__ __forceinline__ void modulate_row(const float* src, const float* g, const float* sh, const float* sc, bf16_t* dst, int lane) {
    f32x4 v[4]; float ss = 0.f;
#pragma unroll
    for (int j = 0; j < 4; ++j) { v[j] = *(const f32x4*)(src + 4 * lane + 256 * j); ss += (v[j][0] * v[j][0] + v[j][1] * v[j][1]) + (v[j][2] * v[j][2] + v[j][3] * v[j][3]); }
    const float rinv = rsqrtf(wave_sum(ss) * (1.f / 1024.f) + EPSN);
#pragma unroll
    for (int j = 0; j < 4; ++j) {
        const int c = 4 * lane + 256 * j;
        const f32x4 gg = *(const f32x4*)(g + c), s1 = *(const f32x4*)(sc + c), s0 = *(const f32x4*)(sh + c);
        f32x4 h;
#pragma unroll
        for (int e = 0; e < 4; ++e) h[e] = v[j][e] * rinv * gg[e] * (1.f + s1[e]) + s0[e];
        u32x2 w; w.x = cvt_pk_bf16(h[0], h[1]); w.y = cvt_pk_bf16(h[2], h[3]);
        *(u32x2*)(dst + c) = w;
    }
}

__host__ __device__ constexpr bool navalid(int g, int t) { return (g == 0) ? (t < 2) : (g == 3) ? (t >= 2) : true; }
__host__ __device__ constexpr int napidx(int g, int t) { int n = 0; for (int gg = 0; gg < 4; ++gg) for (int tt = 0; tt < 4; ++tt) { if (gg == g && tt == t) return n; if (navalid(gg, tt)) ++n; } return n; }

template <int T0, int T1>
__device__ __forceinline__ void na_kload(bf16x8 (&kf)[4][2], const char* kbase, unsigned koff) {
#pragma unroll
    for (int t = T0; t < T1; ++t)
#pragma unroll
        for (int kh = 0; kh < 2; ++kh) kf[t][kh] = *(const bf16x8*)(kbase + ((32 * (t >> 1) + 4 * (t & 1)) * 128 + kh * 64) + (size_t)koff);
}

template <bool LOCAL>
__device__ __forceinline__ void na_step(f32x4 (&o)[4][4], LAS const bf16x8* qlds, float (&mrow)[4], float (&lsum)[4], const bf16x8 (&kf)[4][2], const bf16x8 (&vf)[4][2],
                                        LAS const float* rpbrow, unsigned long long vmask_in) {
    unsigned vm_lo = (unsigned)vmask_in, vm_hi = (unsigned)(vmask_in >> 32);
    asm volatile("" : "+v"(vm_lo), "+v"(vm_hi));
    const f32x4 zero = {0.f, 0.f, 0.f, 0.f};
#pragma unroll
    for (int g = 0; g < 4; ++g) {
        f32x4 s[4];
        float mx = -1e30f;
        const bf16x8 q0 = qlds[(g * 2 + 0) * 64], q1 = qlds[(g * 2 + 1) * 64];
#pragma unroll
        for (int t = 0; t < 4; ++t) {
            if (!LOCAL || navalid(g, t)) {
                f32x4 a = mfma16(kf[t][0], q0, zero); a = mfma16(kf[t][1], q1, a);
                if (LOCAL) {
                    if (g == 1 || g == 2) {
#pragma unroll
                        for (int j = 0; j < 4; ++j) a[j] += rpbrow[15 * 128 + 32 * (t >> 1) + 4 * (t & 1) + j - 16 * g];
                    } else {
#pragma unroll
                        for (int j = 0; j < 4; ++j) {
                            const float bias = rpbrow[32 * (t >> 1) + 4 * (t & 1) + j - 16 * g];
                            const int bit = napidx(g, t) * 4 + j;
                            const bool ok = ((bit < 32 ? (vm_lo >> (bit & 31)) : (vm_hi >> (bit & 31))) & 1u) != 0u;
                            a[j] = ok ? (a[j] + bias) : -1e30f;
                        }
                    }
                }
                s[t] = a;
                mx = fmaxf(mx, fmaxf(fmaxf(a[0], a[1]), fmaxf(a[2], a[3])));
            } else s[t] = zero;
        }
        if (__any(mx > mrow[g] + 16.f)) {
            mx = fmaxf(mx, __shfl_xor(mx, 16)); mx = fmaxf(mx, __shfl_xor(mx, 32));
            const float mnew = fmaxf(mrow[g], mx), alpha = fexp2(mrow[g] - mnew); mrow[g] = mnew;
            lsum[g] = lsum[g] * alpha;
#pragma unroll
            for (int dt = 0; dt < 4; ++dt) o[g][dt] = o[g][dt] * alpha;
        }
        const float mref = mrow[g];
        float psum = 0.f;
#pragma unroll
        for (int t = 0; t < 4; ++t) if (!LOCAL || navalid(g, t)) {
#pragma unroll
            for (int j = 0; j < 4; ++j) { const float p = fexp2(s[t][j] - mref); psum += p; s[t][j] = p; }
        }
        lsum[g] += psum;
#pragma unroll
        for (int sl = 0; sl < 2; ++sl) {
            if (!LOCAL || navalid(g, 2 * sl)) {
                u32x4 w; w.x = cvt_pk_bf16(s[2 * sl][0], s[2 * sl][1]); w.y = cvt_pk_bf16(s[2 * sl][2], s[2 * sl][3]);
                w.z = cvt_pk_bf16(s[2 * sl + 1][0], s[2 * sl + 1][1]); w.w = cvt_pk_bf16(s[2 * sl + 1][2], s[2 * sl + 1][3]);
                const bf16x8 pf = __builtin_bit_cast(bf16x8, w);
#pragma unroll
                for (int dt = 0; dt < 4; ++dt) o[g][dt] = mfma16(vf[dt][sl], pf, o[g][dt]);
            }
        }
    }
}

__device__ __forceinline__ void na_issue(LAS unsigned char* img, int w4, const bf16_t* kb, const bf16_t* vb, unsigned koff, unsigned voff) {
    if (w4 < 2) {
        const char* base = (const char*)kb + (size_t)(4096 * w4); LAS unsigned char* dst = img + w4 * 4096;
#pragma unroll
        for (int i = 0; i < 4; ++i) __builtin_amdgcn_global_load_lds((const unsigned*)(base + (512 * (i >> 1) + 64 * (i & 1)) + (size_t)koff), (LAS unsigned*)(dst + i * 1024), 16, 0, 0);
    } else {
        const char* base = (const char*)vb + (size_t)(2048 * (w4 - 2)); LAS unsigned char* dst = img + 8192 + (w4 - 2) * 4096;
#pragma unroll
        for (int i = 0; i < 4; ++i) __builtin_amdgcn_global_load_lds((const unsigned*)(base + (1024 * (i >> 1) + 4096 * (i & 1)) + (size_t)voff), (LAS unsigned*)(dst + i * 1024), 16, 0, 0);
    }
}
__device__ __forceinline__ void na_unit(int b, int h, int rg, int wave, int lane, unsigned char* ws, LAS const float* rpbS, LAS unsigned char* ldsb) {
    const bf16_t* NQ = (const bf16_t*)(ws + WS_NQ); const bf16_t* NK = (const bf16_t*)(ws + WS_NK); const bf16_t* NVT = (const bf16_t*)(ws + WS_NVT);
    const int r = lane & 15, q = lane >> 4;
    const int row = rg * 8 + wave;
    const int r0 = min(max(row - 4, 0), 56);
    const int umin = min(max(rg * 8 - 4, 0), 56);
    const size_t qtok = (size_t)b * 4096 + (size_t)row * 64;
    const bf16_t* KH = NK + ((size_t)((b * 8 + h) * 4096)) * 64;
    const bf16_t* KC = NK + (size_t)ML * 512 + ((size_t)((b * 8 + h) * 256)) * 64;
    const bf16_t* VH = NVT + ((size_t)((b * 8 + h) * 128)) * 2048;
    const bf16_t* VC = NVT + TL_LAT + ((size_t)((b * 8 + h) * 8)) * 2048;
    const unsigned koff = (unsigned)(((8 * (r >> 2) + (r & 3)) * 64 + 8 * q) * 2), voff = (unsigned)((r * 32 + 8 * q) * 2);
    LAS bf16x8* qlds = (LAS bf16x8*)(ldsb + wave * 8192) + lane;
    LAS unsigned char* imgs = ldsb + 65536;
    const int slot_w = wave >> 2, w4 = wave & 3;
    {
        const int ka = umin + ((0 - umin) & 7); const int kr = min(ka + 8 * slot_w, 63);
        na_issue(imgs + slot_w * 16384, w4, KH + (size_t)kr * 4096, VH + (size_t)kr * 4096, koff, voff);
    }
#pragma unroll
    for (int g = 0; g < 4; ++g)
#pragma unroll
        for (int kh = 0; kh < 2; ++kh) qlds[(g * 2 + kh) * 64] = *(const bf16x8*)((const char*)(NQ + ((size_t)((b * 8 + h) * 4096 + row * 64)) * 64) + ((16 * g) * 128 + kh * 64) + (size_t)(unsigned)((r * 64 + 8 * q) * 2));
    f32x4 o[4][4]; float mrow[4], lsum[4];
#pragma unroll
    for (int g = 0; g < 4; ++g) { mrow[g] = -1e30f; lsum[g] = 0.f;
#pragma unroll
        for (int dt = 0; dt < 4; ++dt) o[g][dt] = (f32x4){0.f, 0.f, 0.f, 0.f}; }
    unsigned long long vmask = 0ull;
#pragma unroll
    for (int g = 0; g < 4; ++g)
#pragma unroll
        for (int t = 0; t < 4; ++t) if (navalid(g, t)) {
#pragma unroll
            for (int j = 0; j < 4; ++j) {
                const int kc = 32 * (t >> 1) + 8 * q + 4 * (t & 1) + j, qc = 16 * g + r, c0 = min(max(qc - 8, 0), 48);
                if (kc >= c0 && kc < c0 + 16) vmask |= 1ull << (napidx(g, t) * 4 + j);
            }
        }
    const int lanebase = 63 + 8 * q - r;
#define NA_FRONT(n)                                                                                                                                   \
        asm volatile("s_waitcnt vmcnt(0)" ::: "memory");                                       \
        __syncthreads();                                                    \
        LAS unsigned char* cur = imgs + ((n) & 1) * 32768;                                                                                          \
        if ((n) + 1 < 12) {                                                                                  \
            LAS unsigned char* nxt = imgs + (((n) + 1) & 1) * 32768 + slot_w * 16384;                                                              \
            if ((n) + 1 < 8) { const int ka_ = umin + (((n) + 1 - umin) & 7); const int kr_ = min(ka_ + 8 * slot_w, 63); na_issue(nxt, w4, KH + (size_t)kr_ * 4096, VH + (size_t)kr_ * 4096, koff, voff); } \
            else if (slot_w == 0) { const int cs_ = (n) + 1 - 8; na_issue(nxt, w4, KC + (size_t)cs_ * 4096, VC + (size_t)cs_ * 4096, koff, voff); }  \
        }
#define NA_READ(slot)                                                                                                                                  \
        LAS const bf16x8* im = (LAS const bf16x8*)(cur + (slot) * 16384) + lane;                                                                    \
        bf16x8 kf[4][2], vf[4][2];                                                                                                                    \
        _Pragma("unroll") for (int t = 0; t < 4; ++t) _Pragma("unroll") for (int kh = 0; kh < 2; ++kh) kf[t][kh] = im[(t * 2 + kh) * 64];       \
        _Pragma("unroll") for (int dt = 0; dt < 4; ++dt) _Pragma("unroll") for (int s2 = 0; s2 < 2; ++s2) vf[dt][s2] = im[(8 + dt * 2 + s2) * 64];
#pragma unroll 1
    for (int n = 0; n < 8; ++n) {
        NA_FRONT(n)
        const int ka = umin + ((n - umin) & 7), kw = r0 + ((n - r0) & 7);
        const int myslot = (kw == ka) ? 0 : 1, ridx = kw - row + 7;
        NA_READ(myslot)
        na_step<true>(o, qlds, mrow, lsum, kf, vf, rpbS + ridx * 128 + lanebase, vmask);
    }
#pragma unroll 1
    for (int n = 8; n < 12; ++n) {
        NA_FRONT(n)
        NA_READ(0)
        na_step<false>(o, qlds, mrow, lsum, kf, vf, rpbS, 0ull);
    }
#undef NA_FRONT
#undef NA_READ
    int lane2 = lane; asm volatile("" : "+v"(lane2));
    const unsigned ooff = (unsigned)(((lane2 & 15) * 64 + 4 * (lane2 >> 4)) * 2);
    char* YNA = (char*)((bf16_t*)(ws + WS_YNA) + ((((qtok >> 8) * 8 + h) * 256 + (qtok & 255)) * 64));
#pragma unroll
    for (int g = 0; g < 4; ++g) {
        float l = lsum[g]; l += __shfl_xor(l, 16); l += __shfl_xor(l, 32);
        const float inv = frcp(l);
#pragma unroll
        for (int dt = 0; dt < 4; ++dt) {
            u32x2 w; w.x = cvt_pk_bf16(o[g][dt][0] * inv, o[g][dt][1] * inv); w.y = cvt_pk_bf16(o[g][dt][2] * inv, o[g][dt][3] * inv);
            *(u32x2*)(YNA + ((16 * g) * 128 + 32 * dt) + (size_t)ooff) = w;
        }
    }
}

__device__ __forceinline__ bf16x8 scale8(bf16x8 v, const float (&w)[8]) {
    const u32x4 u = __builtin_bit_cast(u32x4, v); u32x4 o;
    o.x = cvt_pk_bf16(bf_lo(u.x) * w[0], bf_hi(u.x) * w[1]); o.y = cvt_pk_bf16(bf_lo(u.y) * w[2], bf_hi(u.y) * w[3]);
    o.z = cvt_pk_bf16(bf_lo(u.z) * w[4], bf_hi(u.z) * w[5]); o.w = cvt_pk_bf16(bf_lo(u.w) * w[6], bf_hi(u.w) * w[7]);
    return __builtin_bit_cast(bf16x8, o);
}
__device__ __forceinline__ void state_unit(int it, int lane, unsigned char* ws, const float* dlog) {
    const int cc = it % NCH, bh = it / NCH, h = bh & 7;
    const int r = lane & 15, q = lane >> 4;
    const size_t tb0 = (cc < 2) ? (TL_LAT + ((size_t)(bh * 8 + 4 * cc)) * 2048) : (((size_t)(bh * 128 + 4 * (cc - 2))) * 2048);
    const bf16_t* VT = (const bf16_t*)(ws + WS_RVT) + tb0;
    const bf16_t* KT = (const bf16_t*)(ws + WS_KTF) + tb0;
    const float lgf = lg2_decay(dlog[h]), lgb = lg2_decay(dlog[8 + h]);
    const f32x4 zero = {0.f, 0.f, 0.f, 0.f};
    f32x4 af[4][4], ab[4][4];
#pragma unroll
    for (int a = 0; a < 4; ++a)
#pragma unroll
        for (int c = 0; c < 4; ++c) { af[a][c] = zero; ab[a][c] = zero; }
#pragma unroll
    for (int ks = 0; ks < 4; ++ks) {
        bf16x8 kq[4], vv[4];
#pragma unroll
        for (int a = 0; a < 4; ++a) { kq[a] = *(const bf16x8*)(KT + (ks * 2048 + (16 * a + r) * 32 + 8 * q)); vv[a] = *(const bf16x8*)(VT + (ks * 2048 + (16 * a + r) * 32 + 8 * q)); }
        float wf[8], wb[8];
#pragma unroll
        for (int e = 0; e < 8; ++e) { const int jl = 32 * ks + 8 * q + e; wf[e] = fexp2(lgf * (float)(127 - jl)); wb[e] = fexp2(lgb * (float)jl); }
#pragma unroll
        for (int c = 0; c < 4; ++c) {
            const bf16x8 vf = scale8(vv[c], wf), vb = scale8(vv[c], wb);
#pragma unroll
            for (int a = 0; a < 4; ++a) { af[a][c] = mfma16(kq[a], vf, af[a][c]); ab[a][c] = mfma16(kq[a], vb, ab[a][c]); }
        }
    }
    float* S = (float*)(ws + WS_SB) + ((size_t)(bh * NCH + cc) * 2) * 4096;
#pragma unroll
    for (int c = 0; c < 4; ++c)
#pragma unroll
        for (int a = 0; a < 4; ++a) { *(f32x4*)(S + (16 * c + r) * 64 + 16 * a + 4 * q) = af[a][c]; *(f32x4*)(S + 4096 + (16 * c + r) * 64 + 16 * a + 4 * q) = ab[a][c]; }
}

__device__ __forceinline__ unsigned long long scan_pack(f32x4 a) { return (unsigned long long)cvt_pk_bf16(a[0], a[1]) | ((unsigned long long)cvt_pk_bf16(a[2], a[3]) << 32); }
__device__ __forceinline__ void scan_item(int it, unsigned char* ws, const float* dlog) {
    const int wit = __builtin_amdgcn_readfirstlane(it >> 6), ln = it & 63;
    const int bh = wit >> 5, dir = (wit >> 4) & 1, dv = ((wit & 15) << 2) | (ln >> 4), i2 = ln & 15, h = bh & 7;
    const float G = fexp2(lg2_decay(dlog[dir * 8 + h]) * 128.f);
    const char* S = (const char*)((const float*)(ws + WS_SB) + ((size_t)(bh * NCH) * 2 + dir) * 4096);
    char* R = (char*)((bf16_t*)(ws + WS_RB) + ((size_t)(bh * 32) * 2 + dir) * 4096);
    const unsigned soff = (unsigned)((dv * 64 + 4 * i2) * 4), roff = (unsigned)((dv * 64 + 4 * i2) * 2);
    f32x4 a[NCH - 1];
    if (dir == 0) {
#pragma unroll
        for (int k = 0; k < NCH - 1; ++k) a[k] = *(const f32x4*)(S + (size_t)k * 32768 + (size_t)soff);
    } else {
#pragma unroll
        for (int k = 0; k < NCH - 1; ++k) { const int cc = (k == 0 ? 1 : (k == 1 ? 0 : 35 - k)); a[k] = *(const f32x4*)(S + (size_t)cc * 32768 + (size_t)soff); }
    }
    f32x4 s0 = a[0];
    s0 = G * s0 + a[1];
    if (dir == 0) {
        *(unsigned long long*)(R + (size_t)roff) = scan_pack(s0);
#pragma unroll
        for (int k = 2; k < NCH - 1; ++k) { s0 = G * s0 + a[k]; *(unsigned long long*)(R + (size_t)(k - 1) * 16384 + (size_t)roff) = scan_pack(s0); }
    } else {
        *(unsigned long long*)(R + (size_t)31 * 16384 + (size_t)roff) = scan_pack(s0);
#pragma unroll
        for (int k = 2; k < NCH - 1; ++k) { s0 = G * s0 + a[k]; *(unsigned long long*)(R + (size_t)(32 - k) * 16384 + (size_t)roff) = scan_pack(s0); }
    }
}

__device__ __forceinline__ void ret_unit(int u, int wv, int lane, unsigned char* ws, const float* dlog, LAS unsigned char* img) {
    const int c = u & 31, bh = u >> 5, b = bh >> 3, h = bh & 7;
    const int r = lane & 15, q = lane >> 4;
    const size_t tok0 = (size_t)b * 4096 + 128 * c;
    const int i0 = 32 * wv + r;
    const size_t hm0 = ((size_t)(bh * 4096 + 128 * c)) * 64;
    const char* qb = (const char*)((const bf16_t*)(ws + WS_RQ) + hm0 + (32 * wv) * 64);
    const char* kb = (const char*)((const bf16_t*)(ws + WS_RK) + hm0);
    const char* vb = (const char*)((const bf16_t*)(ws + WS_RVT) + ((size_t)(bh * 128 + 4 * c)) * 2048);
    const char* rb = (const char*)((const bf16_t*)(ws + WS_RB) + ((size_t)(bh * 32 + c) * 2) * 4096);
    const char* gb = (const char*)((const bf16_t*)(ws + WS_RG) + hm0 + (32 * wv) * 64);
    const unsigned qoff = (unsigned)((r * 64 + 8 * q) * 2), koff = (unsigned)(((8 * (r >> 2) + (r & 3)) * 64 + 8 * q) * 2);
    const unsigned voff = (unsigned)((r * 32 + 8 * q) * 2), roff = (unsigned)((r * 64 + 8 * q) * 2), goff = (unsigned)((r * 64 + 4 * q) * 2), yoff = (unsigned)((r * 64 + 4 * q) * 2);
#pragma unroll
    for (int i = 0; i < 4; ++i) {
        const int t = 2 * wv + (i >> 1), kh = i & 1;
        __builtin_amdgcn_global_load_lds((const unsigned*)(kb + ((32 * (t >> 1) + 4 * (t & 1)) * 128 + kh * 64) + (size_t)koff), (LAS unsigned*)(img + (t * 2 + kh) * 1024), 16, 0, 0);
        __builtin_amdgcn_global_load_lds((const unsigned*)(vb + (1024 * wv + 4096 * i) + (size_t)voff), (LAS unsigned*)(img + 16384 + (wv * 4 + i) * 1024), 16, 0, 0);
        const int dir = wv >> 1, dt = 2 * (wv & 1) + (i >> 1);
        __builtin_amdgcn_global_load_lds((const unsigned*)(rb + (dir * 8192 + (16 * dt) * 128 + kh * 64) + (size_t)roff), (LAS unsigned*)(img + 32768 + ((dir * 4 + dt) * 2 + kh) * 1024), 16, 0, 0);
    }
    bf16x8 qf[2][2];
#pragma unroll
    for (int nt = 0; nt < 2; ++nt)
#pragma unroll
        for (int kh = 0; kh < 2; ++kh) qf[nt][kh] = *(const bf16x8*)(qb + (nt * 2048 + kh * 64) + (size_t)qoff);
    u32x2 gv[2][4];
#pragma unroll
    for (int nt = 0; nt < 2; ++nt)
#pragma unroll
        for (int dt = 0; dt < 4; ++dt) gv[nt][dt] = *(const u32x2*)(gb + (nt * 2048 + 32 * dt) + (size_t)goff);
    const float lgf = lg2_decay(dlog[h]), lgb = lg2_decay(dlog[8 + h]);
    asm volatile("s_waitcnt vmcnt(0)" ::: "memory");
    __syncthreads();
    LAS const bf16x8* im = (LAS const bf16x8*)img + lane;
    const f32x4 zero = {0.f, 0.f, 0.f, 0.f};
    bf16x8 pf[2][4];
#pragma unroll
    for (int s = 0; s < 4; ++s) {
        bf16x8 kf[2][2];
#pragma unroll
        for (int tb = 0; tb < 2; ++tb)
#pragma unroll
            for (int kh = 0; kh < 2; ++kh) kf[tb][kh] = im[((2 * s + tb) * 2 + kh) * 64];
#pragma unroll
        for (int nt = 0; nt < 2; ++nt) {
            unsigned pw[4];
#pragma unroll
            for (int tb = 0; tb < 2; ++tb) {
                f32x4 sc = mfma16(kf[tb][0], qf[nt][0], zero); sc = mfma16(kf[tb][1], qf[nt][1], sc);
                float p[4];
#pragma unroll
                for (int j = 0; j < 4; ++j) { const int d = (i0 + 16 * nt) - (32 * s + 8 * q + 4 * tb + j); const float w = (d >= 0) ? fexp2(lgf * (float)d) : fexp2(lgb * (float)(-d)); p[j] = sc[j] * w; }
                pw[2 * tb] = cvt_pk_bf16(p[0], p[1]); pw[2 * tb + 1] = cvt_pk_bf16(p[2], p[3]);
            }
            u32x4 w; w.x = pw[0]; w.y = pw[1]; w.z = pw[2]; w.w = pw[3];
            pf[nt][s] = __builtin_bit_cast(bf16x8, w);
        }
    }
    char* yb = (char*)((bf16_t*)(ws + WS_YRET) + ((((tok0 >> 8) * 8 + h) * 256 + (tok0 & 255) + 32 * wv) * 64));
    f32x4 o[2][4];
#pragma unroll
    for (int dt = 0; dt < 4; ++dt) {
        bf16x8 vf[4], rf[2], rk[2];
#pragma unroll
        for (int s = 0; s < 4; ++s) vf[s] = im[(16 + dt * 4 + s) * 64];
#pragma unroll
        for (int kh = 0; kh < 2; ++kh) { rf[kh] = im[(32 + dt * 2 + kh) * 64]; rk[kh] = im[(32 + (4 + dt) * 2 + kh) * 64]; }
#pragma unroll
        for (int nt = 0; nt < 2; ++nt) {
            const int i = i0 + 16 * nt;
            const float wf = fexp2(lgf * (float)(i + 1)), wb = fexp2(lgb * (float)(128 - i));
            f32x4 a = zero;
#pragma unroll
            for (int s = 0; s < 4; ++s) a = mfma16(vf[s], pf[nt][s], a);
            f32x4 cf = mfma16(rf[0], qf[nt][0], zero); cf = mfma16(rf[1], qf[nt][1], cf);
            f32x4 cb = mfma16(rk[0], qf[nt][0], zero); cb = mfma16(rk[1], qf[nt][1], cb);
#pragma unroll
            for (int j = 0; j < 4; ++j) a[j] += wf * cf[j] + wb * cb[j];
            o[nt][dt] = a;
        }
    }
#pragma unroll
    for (int nt = 0; nt < 2; ++nt) {
        float ss = 0.f;
#pragma unroll
        for (int dt = 0; dt < 4; ++dt)
#pragma unroll
            for (int j = 0; j < 4; ++j) ss += o[nt][dt][j] * o[nt][dt][j];
        ss += __shfl_xor(ss, 16); ss += __shfl_xor(ss, 32);
        const float rinv = rsqrtf(ss * (1.f / 64.f) + EPSN);
#pragma unroll
        for (int dt = 0; dt < 4; ++dt) {
            const u32x2 g = gv[nt][dt];
            const float g0 = bf_lo(g.x), g1 = bf_hi(g.x), g2 = bf_lo(g.y), g3 = bf_hi(g.y);
            const float y0 = o[nt][dt][0] * rinv * g0 * frcp(1.f + fexp2(-g0 * LOG2E)), y1 = o[nt][dt][1] * rinv * g1 * frcp(1.f + fexp2(-g1 * LOG2E));
            const float y2 = o[nt][dt][2] * rinv * g2 * frcp(1.f + fexp2(-g2 * LOG2E)), y3 = o[nt][dt][3] * rinv * g3 * frcp(1.f + fexp2(-g3 * LOG2E));
            u32x2 w; w.x = cvt_pk_bf16(y0, y1); w.y = cvt_pk_bf16(y2, y3);
            *(u32x2*)(yb + (nt * 2048 + 32 * dt) + (size_t)yoff) = w;
        }
    }
    __syncthreads();
}

#define XB_TMO      128
#define XB_XCNT(j)  (256  + 64 * (j))
#define XB_XSUB(j)  (1280 + 64 * (j))
#define XB_XGEN(j)  (2304 + 64 * (j))
#define XB_TOP      3328
#define XB_TOPGEN   3392
#define XCD_BAR_WORDS 3456
#define XB_SPIN_CAP (1u << 18)

__device__ __forceinline__ unsigned xb_ld(unsigned* p)              { return __hip_atomic_load(p, __ATOMIC_RELAXED, __HIP_MEMORY_SCOPE_AGENT); }
__device__ __forceinline__ unsigned xb_add(unsigned* p, unsigned v) { return __hip_atomic_fetch_add(p, v, __ATOMIC_RELAXED, __HIP_MEMORY_SCOPE_AGENT); }
__device__ __forceinline__ unsigned xb_xcc_id() { return (unsigned)__builtin_amdgcn_s_getreg((3 << 11) | 20) & 0xFu; }
#define XB_SPIN(cond, bar) do { unsigned _sp = 0; while (cond) { __builtin_amdgcn_s_sleep(1); \
    if ((++_sp & 255u) == 0u) { if (xb_ld(&(bar)[XB_TMO])) break; if (_sp > XB_SPIN_CAP) { atomicAdd(&(bar)[XB_TMO], 1u); break; } } } } while (0)

struct XcdBarrier {
    unsigned* bar; unsigned x;
    volatile LAS unsigned* st;
};

__device__ __forceinline__ XcdBarrier xcd_barrier_post(unsigned* bar, volatile LAS unsigned* st) {
    XcdBarrier b; b.bar = bar; b.x = xb_xcc_id(); b.st = st;
    if (threadIdx.x == 0) (void)xb_add(&bar[XB_XCNT(b.x)], 1u);
    return b;
}
__device__ __forceinline__ void xcd_barrier_complete(unsigned* bar, unsigned x, unsigned& nloc, unsigned& nx) {
    const unsigned G = gridDim.x * gridDim.y * gridDim.z;
    unsigned sum, cnt, mine, sp = 0u;
    for (;;) {
        sum = 0u; cnt = 0u; mine = 0u;
#pragma unroll
        for (unsigned j = 0; j < 16; ++j) { const unsigned c = xb_ld(&bar[XB_XCNT(j)]); sum += c; cnt += (c > 0u) ? 1u : 0u; mine = (j == x) ? c : mine; }
        if (sum == G) break;
        __builtin_amdgcn_s_sleep(1);
        if ((++sp & 255u) == 0u) { if (xb_ld(&bar[XB_TMO])) break; if (sp > XB_SPIN_CAP) { atomicAdd(&bar[XB_TMO], 1u); break; } }
    }
    nloc = mine > 0u ? mine : 1u; nx = cnt > 0u ? cnt : 1u;
}

__device__ __forceinline__ void xcd_barrier(const XcdBarrier& b) {
    asm volatile("s_waitcnt vmcnt(0)" ::: "memory");
    __syncthreads();
    if (threadIdx.x == 0) {
        unsigned* bar = b.bar;
        __builtin_amdgcn_s_waitcnt(0);
        unsigned nloc = b.st[0], nx = b.st[1];
        if (nloc == 0u) { xcd_barrier_complete(bar, b.x, nloc, nx); b.st[0] = nloc; b.st[1] = nx; }
        const unsigned old = xb_add(&bar[XB_XSUB(b.x)], 1u);
        const unsigned gen = old / nloc;
        if (old + 1u == (gen + 1u) * nloc) {
            __builtin_amdgcn_fence(__ATOMIC_RELEASE, "agent");
            asm volatile("s_waitcnt vmcnt(0)" ::: "memory");
            const unsigned og = xb_add(&bar[XB_TOP], 1u);
            const unsigned tg = og / nx;
            if (og + 1u == (tg + 1u) * nx) xb_add(&bar[XB_TOPGEN], 1u);
            else XB_SPIN(xb_ld(&bar[XB_TOPGEN]) == tg, bar);
            __builtin_amdgcn_fence(__ATOMIC_ACQUIRE, "agent");
            xb_add(&bar[XB_XGEN(b.x)], 1u);
            asm volatile("s_waitcnt vmcnt(0)" ::: "memory");
        } else {
            XB_SPIN(xb_ld(&bar[XB_XGEN(b.x)]) == gen, bar);
            __builtin_amdgcn_fence(__ATOMIC_ACQUIRE, "agent");
            asm volatile("s_waitcnt vmcnt(0)" ::: "memory");
        }
    }
    __syncthreads();
}

__device__ __forceinline__ int lane_of(int tid) { int t = tid; asm volatile("" : "+v"(t)); return t & 63; }
struct Args { const float* in[18]; float* outp; unsigned char* wsp; int ph_lo, ph_hi; };
constexpr int NPH = 13;

__global__ void __launch_bounds__(512, 2) mk_fwd(Args a) {
    extern __shared__ __attribute__((aligned(16))) unsigned char lds_raw[];
    LAS unsigned char* lds = (LAS unsigned char*)lds_raw;
    cg::grid_group grid = cg::this_grid();
    const int tid = threadIdx.x, wave = __builtin_amdgcn_readfirstlane(tid >> 6);
#define lane (lane_of(tid))
    const int G = gridDim.x, bx = blockIdx.x;
    if (tid < 64) ((LAS unsigned*)(lds + 131072))[tid] = 0u;
    __syncthreads();
    XcdBarrier xbar = xcd_barrier_post((unsigned*)(a.wsp + WS_BAR), (volatile LAS unsigned*)(lds + 131072));
    const int gw = bx * 8 + wave, NGW = G * 8;
#define ws (a.wsp)
#define XIN (a.in[0])
#define cvec (a.in[1])
#define ctx (a.in[2])
#define cctx (a.in[3])
#define w_ada (a.in[4])
#define b_ada (a.in[5])
#define g_pre_mix (a.in[6])
#define g_post_mix (a.in[7])
#define g_pre_ffn (a.in[8])
#define g_post_ffn (a.in[9])
#define dlog (a.in[11])
#define rpb (a.in[13])
#define MOD ((float*)(a.wsp + WS_MOD))
#define cosT ((float*)(a.wsp + WS_COS))
#define sinT ((float*)(a.wsp + WS_SIN))
#define out (a.outp)
    const int lo = a.ph_lo, hi = a.ph_hi;
#ifndef REP_MASK
#define REP_MASK 0
#endif
#ifndef SYNC_REP
#define SYNC_REP 1
#endif
#define TILE_RC(row, j, ln) ((((size_t)(((row) >> 8) * 4 + (j))) << 16) + (size_t)((((row) & 255) * 256) + 4 * (ln)))
#define IN(k) (lo <= (k) && (k) < hi)
#ifndef REP_CNT
#define REP_CNT 2
#endif
#define REPS(k) (((REP_MASK >> (k)) & 1) ? REP_CNT : 1)
#define SEAM(k) do { if (IN(k) && IN((k) + 1)) { for (int _s = 0; _s < SYNC_REP; ++_s) { if (lo < 0) grid.sync();     xcd_barrier(xbar); } } } while (0)

    if (IN(0)) for (int _rep = 0; _rep < REPS(0); ++_rep) { if (_rep) xcd_barrier(xbar);
        for (int it = bx; it < 192; it += G) ada_item(it, cvec, cctx, w_ada, b_ada, MOD, (LAS float*)lds, tid);
        if (bx == G - 1) {
            for (int idx = tid; idx < 1024; idx += 512) { const int pos = idx >> 4, f = idx & 15; const float inv = exp2f(-(float)f * (13.287712379549449f / 16.f)); const float ang = (float)pos * inv; cosT[idx] = __cosf(ang); sinT[idx] = __sinf(ang); }
        }
        __syncthreads();
        LAS float* scr = (LAS float*)(lds + wave * 8704);
        constexpr int I0 = 16 * 176, I1 = 8 * 32, I2 = 8 * 32, I3 = 16 * 32, I4 = 16 * 128, I5 = 64 * 32;
        const int nconv = (G == 256) ? I0 : (I0 + I1 + I2 + I3 + I4 + I5);
        for (int it = gw; it < nconv; it += NGW) {
            int rr = it;
            if (rr < I0) { conv_item(a.in[10], 1024, INC, 0, ws, scr, rr, lane); continue; } rr -= I0;
            if (rr < I1) { conv_item(a.in[12], 512, 1024, 1, ws, scr, rr, lane); continue; } rr -= I1;
            if (rr < I2) { conv_item(a.in[14], 512, 1024, 2, ws, scr, rr, lane); continue; } rr -= I2;
            if (rr < I3) { conv_item(a.in[15], 1024, 1024, 3, ws, scr, rr, lane); continue; } rr -= I3;
            if (rr < I4) { conv_item(a.in[16], 1024, 4096, 4, ws, scr, rr, lane); continue; } rr -= I4;
            conv_item(a.in[17], 4096, 1024, 5, ws, scr, rr, lane);
        }
    }
    SEAM(0);
    if (IN(1)) for (int _rep = 0; _rep < REPS(1); ++_rep) { if (_rep) xcd_barrier(xbar);
        bf16_t* XN = (bf16_t*)(ws + WS_XN);
        const int ln = lane;
        f32x4 nx[4];
        { const int row = gw; const float* src = (row < ML) ? (XIN + (size_t)row * 1024) : (ctx + (size_t)(row - ML) * 1024);
#pragma unroll
          for (int j = 0; j < 4; ++j) nx[j] = *(const f32x4*)(src + 4 * ln + 256 * j); }
        for (int row = gw; row < MT; row += NGW) {
            f32x4 v[4];
#pragma unroll
            for (int j = 0; j < 4; ++j) v[j] = nx[j];
            const int nrow = row + NGW;
            if (nrow < MT) { const float* src = (nrow < ML) ? (XIN + (size_t)nrow * 1024) : (ctx + (size_t)(nrow - ML) * 1024);
#pragma unroll
                for (int j = 0; j < 4; ++j) nx[j] = *(const f32x4*)(src + 4 * ln + 256 * j); }
            const float* mod = (row < ML) ? (MOD + (row >> 12) * 6144) : (MOD + 8 * 6144);
            float ss = 0.f;
#pragma unroll
            for (int j = 0; j < 4; ++j) ss += (v[j][0] * v[j][0] + v[j][1] * v[j][1]) + (v[j][2] * v[j][2] + v[j][3] * v[j][3]);
            const float rinv = rsqrtf(wave_sum(ss) * (1.f / 1024.f) + EPSN);
#pragma unroll
            for (int j = 0; j < 4; ++j) {
                const int c = 4 * ln + 256 * j;
                const f32x4 gg = *(const f32x4*)(g_pre_mix + c), s1 = *(const f32x4*)(mod + 1024 + c), s0 = *(const f32x4*)(mod + c);
                f32x4 hh;
#pragma unroll
                for (int e = 0; e < 4; ++e) hh[e] = v[j][e] * rinv * gg[e] * (1.f + s1[e]) + s0[e];
                u32x2 w; w.x = cvt_pk_bf16(hh[0], hh[1]); w.y = cvt_pk_bf16(hh[2], hh[3]);
                *(u32x2*)(XN + (size_t)row * 1024 + c) = w;
            }
        }
    }
    SEAM(1);
    if (IN(2)) for (int _rep = 0; _rep < REPS(2); ++_rep) { if (_rep) xcd_barrier(xbar);
        SchedInproj S{(const char*)(ws + WS_XN), (const char*)(ws + WS_WIN1), (const char*)(ws + WS_WIN2), G, bx};
        LAS float* ltab = (LAS float*)(lds + 132096);
        for (int idx = tid; idx < 1024; idx += 512) { ltab[idx] = cosT[idx]; ltab[1024 + idx] = sinT[idx]; }
        __syncthreads();
        EpiInproj E{ws, (bf16_t*)out, ltab, ltab + 1024, dlog};
        pg8::gemm_phase<EpiInproj, SchedInproj, true, true>(lds, 1024, S, E);
        if (G == 256 && bx >= 64) {
            LAS float* scr = (LAS float*)(lds + wave * 8704);
            constexpr int I1 = 8 * 32, I2 = 8 * 32, I3 = 16 * 32, I4 = 16 * 128, I5 = 64 * 32;
            for (int it = (bx - 64) * 8 + wave; it < I1 + I2 + I3 + I4 + I5; it += 192 * 8) {
                int rr = it;
                if (rr < I1) { conv_item(a.in[12], 512, 1024, 1, ws, scr, rr, lane); continue; } rr -= I1;
                if (rr < I2) { conv_item(a.in[14], 512, 1024, 2, ws, scr, rr, lane); continue; } rr -= I2;
                if (rr < I3) { conv_item(a.in[15], 1024, 1024, 3, ws, scr, rr, lane); continue; } rr -= I3;
                if (rr < I4) { conv_item(a.in[16], 1024, 4096, 4, ws, scr, rr, lane); continue; } rr -= I4;
                conv_item(a.in[17], 4096, 1024, 5, ws, scr, rr, lane);
            }
        }
    }
    SEAM(2);
    if (IN(3)) for (int _rep = 0; _rep < REPS(3); ++_rep) { if (_rep) xcd_barrier(xbar);
        for (int it = gw; it < 64 * NCH; it += NGW) state_unit(it, lane, ws, dlog);
        LAS float* rpbS = (LAS float*)(lds + 132096);
        const int vcu = (G % 8 == 0) ? ((bx % 8) * (G / 8) + bx / 8) : bx;
        for (int u = vcu; u < 512; u += G) {
            const int b = u >> 6, h = (u >> 3) & 7, rg = u & 7;
            __syncthreads();
            int t2 = tid; asm volatile("" : "+v"(t2));
            for (int idx = t2; idx < 15 * 128; idx += 512) { const int ri = idx >> 7, ci = (idx & 127) - 48; const float bv = (ci >= 0 && ci < 31) ? rpb[(h * 15 + ri) * 31 + ci] * LOG2E : 0.f;
                rpbS[idx] = bv; rpbS[15 * 128 + idx] = (ci >= 7 && ci <= 22) ? bv : -1e30f; }
            __syncthreads();
            na_unit(b, h, rg, wave, lane, ws, rpbS, lds);
        }
    }
    SEAM(3);
    if (IN(4)) for (int _rep = 0; _rep < REPS(4); ++_rep) { if (_rep) xcd_barrier(xbar);
        for (int it = bx * 512 + tid; it < 64 * 2 * 1024; it += G * 512) scan_item(it, ws, dlog);
    }
    SEAM(4);
    if (IN(5)) for (int _rep = 0; _rep < REPS(5); ++_rep) { if (_rep) xcd_barrier(xbar);
        LAS unsigned char* img = lds + (wave >> 2) * 49152;
        if (G == 256) { for (int k = 0; k < 4; ++k) ret_unit(bx * 8 + 2 * k + (wave >> 2), wave & 3, lane, ws, dlog, img); }
        else { for (int up = bx; up < 1024; up += G) ret_unit(2 * up + (wave >> 2), wave & 3, lane, ws, dlog, img); }
    }
    SEAM(5);
    if (IN(6)) for (int _rep = 0; _rep < REPS(6); ++_rep) { if (_rep) xcd_barrier(xbar);
        SchedSimple S{(const char*)(ws + WS_YRET), (const char*)(ws + WS_WR), 128, 4, G, bx, 0};
        EpiMerge<0> E{(const bf16_t*)out, (bf16_t*)(ws + WS_Z)};
        pg8::gemm_phase<EpiMerge<0>, SchedSimple, true, true, true>(lds, 512, S, E);
    }
    SEAM(6);
    if (IN(7)) for (int _rep = 0; _rep < REPS(7); ++_rep) { if (_rep) xcd_barrier(xbar);
        SchedSimple S{(const char*)(ws + WS_YNA), (const char*)(ws + WS_WN), 128, 4, G, bx, 0};
        EpiMerge<1> E{(const bf16_t*)out, (bf16_t*)(ws + WS_Z)};
        pg8::gemm_phase<EpiMerge<1>, SchedSimple, true, true, true>(lds, 512, S, E);
    }
    SEAM(7);
    if (IN(8)) for (int _rep = 0; _rep < REPS(8); ++_rep) { if (_rep) xcd_barrier(xbar);
        SchedSimple S{(const char*)(ws + WS_Z), (const char*)(ws + WS_WO), 128, 4, G, bx, 0};
        EpiPlain<0, 1> E{(bf16_t*)(ws + WS_Y), 1024};
        pg8::gemm_phase<EpiPlain<0, 1>, SchedSimple, true, true, true>(lds, 1024, S, E);
    }
    SEAM(8);
    if (IN(9)) for (int _rep = 0; _rep < REPS(9); ++_rep) { if (_rep) xcd_barrier(xbar);
        const bf16_t* Y = (const bf16_t*)(ws + WS_Y); bf16_t* H2 = (bf16_t*)(ws + WS_H2);
        const int ln = lane;
        f32x4 nx[4]; u32x2 ny[4];
#pragma unroll
        for (int j = 0; j < 4; ++j) { const int c = 4 * ln + 256 * j; ny[j] = *(const u32x2*)(Y + TILE_RC(gw, j, ln)); nx[j] = *(const f32x4*)(XIN + (size_t)gw * 1024 + c); }
        for (int row = gw; row < ML; row += NGW) {
            const float* mod = MOD + (row >> 12) * 6144;
            f32x4 y[4], xv[4]; float ss = 0.f;
#pragma unroll
            for (int j = 0; j < 4; ++j) {
                const u32x2 w = ny[j];
                y[j][0] = bf_lo(w.x); y[j][1] = bf_hi(w.x); y[j][2] = bf_lo(w.y); y[j][3] = bf_hi(w.y);
                xv[j] = nx[j];
                ss += (y[j][0] * y[j][0] + y[j][1] * y[j][1]) + (y[j][2] * y[j][2] + y[j][3] * y[j][3]);
            }
            const int nrow = row + NGW;
            if (nrow < ML) {
#pragma unroll
                for (int j = 0; j < 4; ++j) { const int c = 4 * ln + 256 * j; ny[j] = *(const u32x2*)(Y + TILE_RC(nrow, j, ln)); nx[j] = *(const f32x4*)(XIN + (size_t)nrow * 1024 + c); }
            }
            const float r1 = rsqrtf(wave_sum(ss) * (1.f / 1024.f) + EPSN);
            float ss2 = 0.f;
#pragma unroll
            for (int j = 0; j < 4; ++j) {
                const int c = 4 * ln + 256 * j;
                const f32x4 gp = *(const f32x4*)(g_post_mix + c), gt = *(const f32x4*)(mod + 2048 + c);
#pragma unroll
                for (int e = 0; e < 4; ++e) { xv[j][e] = xv[j][e] + gt[e] * (y[j][e] * r1 * gp[e]); ss2 += xv[j][e] * xv[j][e]; }
            }
            const float r2 = rsqrtf(wave_sum(ss2) * (1.f / 1024.f) + EPSN);
#pragma unroll
            for (int j = 0; j < 4; ++j) {
                const int c = 4 * ln + 256 * j;
                const f32x4 gg = *(const f32x4*)(g_pre_ffn + c), s0 = *(const f32x4*)(mod + 3072 + c), s1 = *(const f32x4*)(mod + 4096 + c);
                f32x4 hh;
#pragma unroll
                for (int e = 0; e < 4; ++e) hh[e] = xv[j][e] * r2 * gg[e] * (1.f + s1[e]) + s0[e];
                u32x2 w; w.x = cvt_pk_bf16(hh[0], hh[1]); w.y = cvt_pk_bf16(hh[2], hh[3]);
                *(u32x2*)(H2 + ((((size_t)((row >> 8) * 16 + (c >> 6))) * 256 + (row & 255)) * 64 + (c & 63))) = w;
            }
        }
    }
    SEAM(9);
    if (IN(10)) for (int _rep = 0; _rep < REPS(10); ++_rep) { if (_rep) xcd_barrier(xbar);
        SchedSimple S{(const char*)(ws + WS_H2), (const char*)(ws + WS_W1), 128, 16, G, bx, 0};
        EpiPlain<1, 2> E{(bf16_t*)(ws + WS_U), 4096};
        pg8::gemm_phase<EpiPlain<1, 2>, SchedSimple, true, true, true>(lds, 1024, S, E);
    }
    SEAM(10);
    if (IN(11)) for (int _rep = 0; _rep < REPS(11); ++_rep) { if (_rep) xcd_barrier(xbar);
        SchedSimple S{(const char*)(ws + WS_U), (const char*)(ws + WS_W2), 128, 4, G, bx, 0};
        EpiPlain<0, 1> E{(bf16_t*)(ws + WS_H2), 1024};
        pg8::gemm_phase<EpiPlain<0, 1>, SchedSimple, true, true, true>(lds, 4096, S, E);
    }
    SEAM(11);
    if (IN(12)) for (int _rep = 0; _rep < REPS(12); ++_rep) { if (_rep) xcd_barrier(xbar);
        const bf16_t* F = (const bf16_t*)(ws + WS_H2); const bf16_t* Y = (const bf16_t*)(ws + WS_Y);
        const int ln = lane;
        f32x4 nx[4]; u32x2 ny[4], nf[4];
#pragma unroll
        for (int j = 0; j < 4; ++j) { const int c = 4 * ln + 256 * j; nf[j] = *(const u32x2*)(F + TILE_RC(gw, j, ln)); ny[j] = *(const u32x2*)(Y + TILE_RC(gw, j, ln)); nx[j] = *(const f32x4*)(XIN + (size_t)gw * 1024 + c); }
        for (int row = gw; row < ML; row += NGW) {
            const float* mod = MOD + (row >> 12) * 6144;
            f32x4 y[4], f[4], xv[4]; float ss = 0.f, sf = 0.f;
#pragma unroll
            for (int j = 0; j < 4; ++j) {
                const u32x2 w = ny[j], v = nf[j];
                y[j][0] = bf_lo(w.x); y[j][1] = bf_hi(w.x); y[j][2] = bf_lo(w.y); y[j][3] = bf_hi(w.y);
                f[j][0] = bf_lo(v.x); f[j][1] = bf_hi(v.x); f[j][2] = bf_lo(v.y); f[j][3] = bf_hi(v.y);
                xv[j] = nx[j];
                ss += (y[j][0] * y[j][0] + y[j][1] * y[j][1]) + (y[j][2] * y[j][2] + y[j][3] * y[j][3]);
                sf += (f[j][0] * f[j][0] + f[j][1] * f[j][1]) + (f[j][2] * f[j][2] + f[j][3] * f[j][3]);
            }
            const int nrow = row + NGW;
            if (nrow < ML) {
#pragma unroll
                for (int j = 0; j < 4; ++j) { const int c = 4 * ln + 256 * j; nf[j] = *(const u32x2*)(F + TILE_RC(nrow, j, ln)); ny[j] = *(const u32x2*)(Y + TILE_RC(nrow, j, ln)); nx[j] = *(const f32x4*)(XIN + (size_t)nrow * 1024 + c); }
            }
#pragma unroll
            for (int o2 = 1; o2 < 64; o2 <<= 1) { ss += __shfl_xor(ss, o2); sf += __shfl_xor(sf, o2); }
            const float r1 = rsqrtf(ss * (1.f / 1024.f) + EPSN), r2 = rsqrtf(sf * (1.f / 1024.f) + EPSN);
#pragma unroll
            for (int j = 0; j < 4; ++j) {
                const int c = 4 * ln + 256 * j;
                const f32x4 gp = *(const f32x4*)(g_post_mix + c), gt = *(const f32x4*)(mod + 2048 + c);
                const f32x4 gq = *(const f32x4*)(g_post_ffn + c), gu = *(const f32x4*)(mod + 5120 + c);
#pragma unroll
                for (int e = 0; e < 4; ++e) { const float x1 = xv[j][e] + gt[e] * (y[j][e] * r1 * gp[e]); xv[j][e] = x1 + gu[e] * (f[j][e] * r2 * gq[e]); }
                *(f32x4*)(out + (size_t)row * 1024 + c) = xv[j];
            }
        }
    }
#undef IN
#undef SEAM
#undef lane
#undef ws
#undef XIN
#undef cvec
#undef ctx
#undef cctx
#undef w_ada
#undef b_ada
#undef g_pre_mix
#undef g_post_mix
#undef g_pre_ffn
#undef g_post_ffn
#undef dlog
#undef rpb
#undef MOD
#undef cosT
#undef sinT
#undef out
}

#ifndef MK_MULTI
#define MK_MULTI 0
#endif
extern "C" void kernel_launch(void* const* d_in, const int* in_sizes, int n_in, void* d_out, int out_size, void* d_ws, size_t ws_size, hipStream_t stream) {
    static int grid = 0;
    if (grid == 0) {
        if (n_in != 18 || out_size != ML * DM || ws_size < WS_END) { fprintf(stderr, "kernel_launch: unexpected problem (n_in %d out %d ws %zu)\n", n_in, out_size, ws_size); grid = -1; return; }
        int dev = 0, cus = 0, per_cu = 0;
        if (hipGetDevice(&dev) != hipSuccess || hipDeviceGetAttribute(&cus, hipDeviceAttributeMultiprocessorCount, dev) != hipSuccess) { grid = -1; return; }
        if (hipFuncSetAttribute((const void*)mk_fwd, hipFuncAttributeMaxDynamicSharedMemorySize, LDS_BYTES) != hipSuccess) { fprintf(stderr, "kernel_launch: hipFuncSetAttribute failed\n"); grid = -1; return; }
        if (hipOccupancyMaxActiveBlocksPerMultiprocessor(&per_cu, (const void*)mk_fwd, 512, LDS_BYTES) != hipSuccess || per_cu < 1) { fprintf(stderr, "kernel_launch: occupancy query says %d\n", per_cu); (void)hipGetLastError(); grid = -1; return; }
        grid = cus;
    }
    if (grid < 0) return;
    if (hipMemsetAsync((char*)d_ws + WS_BAR, 0, 16384, stream) != hipSuccess) { fprintf(stderr, "kernel_launch: memset failed\n"); return; }
    Args a{};
    for (int i = 0; i < 18; ++i) a.in[i] = (const float*)d_in[i];
    a.outp = (float*)d_out; a.wsp = (unsigned char*)d_ws;
#if MK_MULTI
    for (int p = 0; p < NPH; ++p) { a.ph_lo = p; a.ph_hi = p + 1; hipLaunchKernelGGL(mk_fwd, dim3(grid), dim3(512), LDS_BYTES, stream, a); }
#else
    a.ph_lo = 0; a.ph_hi = NPH;
    void* args[] = {&a};
    hipError_t e = hipLaunchCooperativeKernel((const void*)mk_fwd, dim3(grid), dim3(512), args, LDS_BYTES, stream);
    if (e != hipSuccess) fprintf(stderr, "kernel_launch: cooperative launch failed: %s (grid %d)\n", hipGetErrorString(e), grid);
#endif
}
```
